# Optimizing an MI355X kernel written in HIP

```python
import math
import jax, jax.numpy as jnp
from jax import lax
import numpy as np

D_MODEL = 2048
BATCH = 4
SEQ = 4096
DEPTH = 2

MIX_WIDTH = D_MODEL
RET_HEADS = 4
RET_WIDTH = MIX_WIDTH // 4
RET_DIM = RET_WIDTH // RET_HEADS
RET_CHUNK = 128
RET_ROPE_THETA = 10000.0
DIFF_HEADS = 4
DIFF_WIDTH = MIX_WIDTH // 2
DIFF_V_DIM = DIFF_WIDTH // DIFF_HEADS
DIFF_QK_DIM = DIFF_V_DIM // 2
DIFF_ROT_DIM = DIFF_QK_DIM // 4
ROPE_THETA = 500000.0
Q_BLOCK = 128
MLSTM_HEADS = 4
MLSTM_WIDTH = MIX_WIDTH // 4
MLSTM_DIM = MLSTM_WIDTH // MLSTM_HEADS
MLSTM_CHUNK = 64
CONV_K = 4
D_FF = ((8 * D_MODEL // 3 + 127) // 128) * 128
ALPHA = (2 * DEPTH) ** 0.25
BETA = (8 * DEPTH) ** -0.25
PROJ_SPLITS = (
    RET_WIDTH, RET_WIDTH, RET_WIDTH, RET_WIDTH,
    2 * DIFF_HEADS * DIFF_QK_DIM, 2 * DIFF_HEADS * DIFF_QK_DIM,
    DIFF_WIDTH,
    MLSTM_WIDTH, MLSTM_WIDTH, MLSTM_WIDTH, MLSTM_WIDTH,
    MLSTM_HEADS, MLSTM_HEADS,
)
PROJ_WIDTH = sum(PROJ_SPLITS)
PROJ_OFFSETS = tuple(int(o) for o in np.cumsum(PROJ_SPLITS)[:-1])

kernel_name = "hymba_style_retention_diffattn_mlstm_macaron_deepnorm"

F32 = jnp.float32


def layer_norm(x, g, b, eps=1e-5):
    xf = x.astype(F32)
    mu = jnp.mean(xf, axis=-1, keepdims=True)
    xc = xf - mu
    var = jnp.mean(xc * xc, axis=-1, keepdims=True)
    return (xc * lax.rsqrt(var + eps) * g + b).astype(x.dtype)


def head_norm(t, g, rms, eps=1e-6):
    if rms:
        y = t * lax.rsqrt(jnp.mean(t * t, axis=-1, keepdims=True) + eps)
    else:
        tc = t - jnp.mean(t, axis=-1, keepdims=True)
        y = tc * lax.rsqrt(jnp.mean(tc * tc, axis=-1, keepdims=True) + eps)
    return y * g


def swiglu(x, w_gu, w_down):
    a, u = jnp.split(x @ w_gu, 2, axis=-1)
    return (jax.nn.silu(a) * u) @ w_down


def rope_tables(seq, rot_dim, theta):
    pos = jnp.arange(seq, dtype=F32)
    inv = theta ** (-jnp.arange(0, rot_dim, 2, dtype=F32) / rot_dim)
    ang = pos[:, None] * inv[None, :]
    return jnp.cos(ang), jnp.sin(ang)


def apply_rotary(t, cos, sin, rot_dim):
    half = rot_dim // 2
    t1, t2, tp = t[..., :half], t[..., half:rot_dim], t[..., rot_dim:]
    return jnp.concatenate([t1 * cos - t2 * sin, t1 * sin + t2 * cos, tp], axis=-1).astype(t.dtype)


def split_heads(t, n_heads):
    B, S, W = t.shape
    return t.reshape(B, S, n_heads, W // n_heads).transpose(0, 2, 1, 3)


def merge_heads(t):
    B, H, S, d = t.shape
    return t.transpose(0, 2, 1, 3).reshape(B, S, H * d)


def to_chunks(t, c):
    B, H, S = t.shape[:3]
    t = t.reshape((B, H, S // c, c) + t.shape[3:])
    return jnp.moveaxis(t, 2, 0)


def from_chunks(t):
    n, B, H, c, d = t.shape
    return jnp.moveaxis(t, 0, 2).reshape(B, H, n * c, d)


def retention_chunkwise(q, k, v):
    B, H, S, d = q.shape
    C = RET_CHUNK
    k = k * (d ** -0.5)
    log_g = jnp.log(1.0 - jnp.exp2(-5.0 - jnp.arange(H, dtype=F32)))
    idx = jnp.arange(C, dtype=F32)
    rel = idx[:, None] - idx[None, :]
    decay_in = jnp.where(rel >= 0, jnp.exp(jnp.maximum(rel, 0.0) * log_g[:, None, None]), 0.0)
    xi = jnp.exp((idx + 1.0)[None, :] * log_g[:, None])[None, :, :, None]
    zeta = jnp.exp((C - 1.0 - idx)[None, :] * log_g[:, None])[None, :, :, None]
    g_chunk = jnp.exp(C * log_g)[None, :, None, None]

    def step(R, inp):
        qc, kc, vc = inp
        inner = jnp.einsum('bhid,bhjd->bhij', qc, kc) * decay_in
        y = (jnp.einsum('bhij,bhjv->bhiv', inner, vc)
             + jnp.einsum('bhid,bhdv->bhiv', qc, R) * xi)
        R = g_chunk * R + jnp.einsum('bhjd,bhjv->bhdv', kc * zeta, vc)
        return R, y

    R0 = jnp.zeros((B, H, d, v.shape[-1]), F32)
    _, ys = lax.scan(step, R0, (to_chunks(q, C), to_chunks(k, C), to_chunks(v, C)))
    return from_chunks(ys)


def diff_attention(q, k, v, lam):
    B, H, _, S, dq = q.shape
    nb = S // Q_BLOCK
    scale = dq ** -0.5
    qb = jnp.moveaxis(q.reshape(B, H, 2, nb, Q_BLOCK, dq), 3, 0)
    kpos = jnp.arange(S)
    vf = v.astype(F32)

    def block(args):
        qblk, bi = args
        s = jnp.einsum('bhmqd,bhmkd->bhmqk', qblk, k).astype(F32) * scale
        qpos = bi * Q_BLOCK + jnp.arange(Q_BLOCK)
        s = jnp.where(kpos[None, :] <= qpos[:, None], s, -jnp.inf)
        p = jax.nn.softmax(s, axis=-1)
        a = p[:, :, 0] - lam * p[:, :, 1]
        return jnp.einsum('bhqk,bhkv->bhqv', a, vf)

    o = lax.map(block, (qb, jnp.arange(nb)))
    return from_chunks(o)


def mlstm_chunkwise(q, k, v, i_pre, f_pre):
    B, H, S, d = q.shape
    L = MLSTM_CHUNK
    k = k * (d ** -0.5)
    log_f = jax.nn.log_sigmoid(f_pre)
    tril = jnp.tril(jnp.ones((L, L), dtype=bool))

    def step(carry, inp):
        Cs, ns, m = carry
        qc, kc, vc, ic, lfc = inp
        b = jnp.cumsum(lfc, axis=-1)
        a = b + m[..., None]
        Dm = jnp.where(tril, b[..., :, None] - b[..., None, :] + ic[..., None, :], -jnp.inf)
        mt = jnp.maximum(a, jnp.max(Dm, axis=-1))
        sc = jnp.einsum('bhid,bhjd->bhij', qc, kc) * jnp.exp(Dm - mt[..., None])
        inter = jnp.exp(a - mt)
        num = (jnp.einsum('bhij,bhjv->bhiv', sc, vc)
               + inter[..., None] * jnp.einsum('bhid,bhdv->bhiv', qc, Cs))
        den = jnp.sum(sc, axis=-1) + inter * jnp.einsum('bhid,bhd->bhi', qc, ns)
        h = num / jnp.maximum(jnp.abs(den), jnp.exp(-mt))[..., None]
        bL = b[..., -1]
        w_log = bL[..., None] - b + ic
        m_new = jnp.maximum(bL + m, jnp.max(w_log, axis=-1))
        dec = jnp.exp(bL + m - m_new)
        kw = kc * jnp.exp(w_log - m_new[..., None])[..., None]
        Cs = dec[..., None, None] * Cs + jnp.einsum('bhjd,bhjv->bhdv', kw, vc)
        ns = dec[..., None] * ns + jnp.sum(kw, axis=2)
        return (Cs, ns, m_new), h

    init = (jnp.zeros((B, H, d, d), F32), jnp.zeros((B, H, d), F32), jnp.zeros((B, H), F32))
    _, hs = lax.scan(step, init, (to_chunks(q, L), to_chunks(k, L), to_chunks(v, L),
                                  to_chunks(i_pre, L), to_chunks(log_f, L)))
    return from_chunks(hs)


def causal_dwconv_silu(u, w, b):
    S = u.shape[1]
    up = jnp.pad(u, ((0, 0), (CONV_K - 1, 0), (0, 0)))
    y = b + sum(up[:, j:j + S, :] * w[j] for j in range(CONV_K))
    return jax.nn.silu(y)


def token_mixer(h, w_in, ret_norm_g, diff_lambda, diff_norm_g, conv_w, conv_b, gate_b,
                mlstm_norm_g, w_out, lam_init, ret_cs, diff_cs):
    B, S, _ = h.shape
    proj = h @ w_in
    (rq, rk, rv, rg, dq, dk, dv, mq, mk, mv, mo, mi, mf) = jnp.split(proj, PROJ_OFFSETS, axis=-1)

    rcos, rsin = ret_cs
    rq = apply_rotary(split_heads(rq, RET_HEADS).astype(F32), rcos, rsin, RET_DIM)
    rk = apply_rotary(split_heads(rk, RET_HEADS).astype(F32), rcos, rsin, RET_DIM)
    ry = retention_chunkwise(rq, rk, split_heads(rv, RET_HEADS).astype(F32))
    ry = head_norm(ry, ret_norm_g.reshape(RET_HEADS, 1, RET_DIM), rms=False)
    ret_out = jax.nn.silu(rg.astype(F32)) * merge_heads(ry)

    dcos, dsin = diff_cs
    def qk_heads(t):
        t = t.reshape(B, S, DIFF_HEADS, 2, DIFF_QK_DIM).transpose(0, 2, 3, 1, 4)
        return apply_rotary(t.astype(F32), dcos, dsin, DIFF_ROT_DIM)
    dl = diff_lambda.astype(F32)
    lam = (jnp.exp(jnp.sum(dl[0] * dl[1])) - jnp.exp(jnp.sum(dl[2] * dl[3])) + lam_init)
    dy = diff_attention(qk_heads(dq), qk_heads(dk), split_heads(dv, DIFF_HEADS), lam)
    dy = head_norm(dy, diff_norm_g, rms=True) * (1.0 - lam_init)
    diff_out = merge_heads(dy)

    mqk = causal_dwconv_silu(jnp.concatenate([mq, mk], axis=-1), conv_w, conv_b)
    mq_c, mk_c = jnp.split(mqk.astype(F32), 2, axis=-1)
    i_pre = (mi.astype(F32) + gate_b[0]).transpose(0, 2, 1)
    f_pre = (mf.astype(F32) + gate_b[1]).transpose(0, 2, 1)
    mh = mlstm_chunkwise(split_heads(mq_c, MLSTM_HEADS), split_heads(mk_c, MLSTM_HEADS),
                         split_heads(mv, MLSTM_HEADS).astype(F32), i_pre, f_pre)
    mh = jax.nn.sigmoid(split_heads(mo, MLSTM_HEADS).astype(F32)) * mh
    mh = head_norm(mh, mlstm_norm_g.reshape(MLSTM_HEADS, 1, MLSTM_DIM), rms=False)
    mlstm_out = merge_heads(mh)

    mixed = jnp.concatenate([ret_out, diff_out, mlstm_out], axis=-1).astype(h.dtype)
    return mixed @ w_out


def setup_inputs(seed: int = 0) -> dict:
    key = jax.random.key(seed)
    ks = jax.random.split(key, 20)
    nrm = lambda k, shape, s: jax.random.normal(k, shape, F32) * s
    gate_b = jnp.stack([
        nrm(ks[12], (DEPTH, MLSTM_HEADS), 0.1),
        jnp.linspace(3.0, 6.0, MLSTM_HEADS, dtype=F32)[None, :] + nrm(ks[13], (DEPTH, MLSTM_HEADS), 0.1),
    ], axis=1)
    return {
        "x": nrm(ks[0], (BATCH, SEQ, D_MODEL), 1.0),
        "ln_g": 1.0 + nrm(ks[1], (DEPTH, 3, D_MODEL), 0.02),
        "ln_b": nrm(ks[2], (DEPTH, 3, D_MODEL), 0.02),
        "ffn1_w_gu": nrm(ks[3], (DEPTH, D_MODEL, 2 * D_FF), D_MODEL ** -0.5),
        "ffn1_w_down": nrm(ks[4], (DEPTH, D_FF, D_MODEL), BETA * D_FF ** -0.5),
        "w_in": nrm(ks[5], (DEPTH, D_MODEL, PROJ_WIDTH), D_MODEL ** -0.5),
        "ret_norm_g": 1.0 + nrm(ks[6], (DEPTH, RET_WIDTH), 0.02),
        "diff_lambda": nrm(ks[7], (DEPTH, 4, DIFF_QK_DIM), 0.1),
        "diff_norm_g": 1.0 + nrm(ks[8], (DEPTH, DIFF_V_DIM), 0.02),
        "mlstm_conv_w": nrm(ks[9], (DEPTH, CONV_K, 2 * MLSTM_WIDTH), CONV_K ** -0.5),
        "mlstm_conv_b": nrm(ks[10], (DEPTH, 2 * MLSTM_WIDTH), 0.02),
        "mlstm_gate_b": gate_b,
        "mlstm_norm_g": 1.0 + nrm(ks[11], (DEPTH, MLSTM_WIDTH), 0.02),
        "w_out": nrm(ks[14], (DEPTH, MIX_WIDTH, D_MODEL), BETA * MIX_WIDTH ** -0.5),
        "ffn2_w_gu": nrm(ks[15], (DEPTH, D_MODEL, 2 * D_FF), D_MODEL ** -0.5),
        "ffn2_w_down": nrm(ks[16], (DEPTH, D_FF, D_MODEL), BETA * D_FF ** -0.5),
    }


def reference(x, ln_g, ln_b, ffn1_w_gu, ffn1_w_down, w_in, ret_norm_g, diff_lambda, diff_norm_g,
              mlstm_conv_w, mlstm_conv_b, mlstm_gate_b, mlstm_norm_g, w_out, ffn2_w_gu, ffn2_w_down):
    S = x.shape[1]
    ret_cs = rope_tables(S, RET_DIM, RET_ROPE_THETA)
    diff_cs = rope_tables(S, DIFF_ROT_DIM, ROPE_THETA)
    for l in range(DEPTH):
        lam_init = 0.8 - 0.6 * math.exp(-0.3 * l)
        x = layer_norm(ALPHA * x + 0.5 * swiglu(x, ffn1_w_gu[l], ffn1_w_down[l]), ln_g[l, 0], ln_b[l, 0])
        x = layer_norm(ALPHA * x + token_mixer(x, w_in[l], ret_norm_g[l], diff_lambda[l], diff_norm_g[l],
                                               mlstm_conv_w[l], mlstm_conv_b[l], mlstm_gate_b[l],
                                               mlstm_norm_g[l], w_out[l], lam_init, ret_cs, diff_cs),
                       ln_g[l, 1], ln_b[l, 1])
        x = layer_norm(ALPHA * x + 0.5 * swiglu(x, ffn2_w_gu[l], ffn2_w_down[l]), ln_g[l, 2], ln_b[l, 2])
    return x
```

```cpp
#include <hip/hip_runtime.h>
#include <hip/hip_bf16.h>
#include <hip/hip_cooperative_groups.h>
#include <cstdio>
#include <cstdint>
namespace cg = cooperative_groups;
__device__ __forceinline__ int opq_tid() { int t = (int)threadIdx.x; asm volatile("" : "+v"(t)); return t; }
__device__ __forceinline__ int opq_bid() { int t = (int)blockIdx.x; asm volatile("" : "+s"(t)); return t; }
__device__ __forceinline__ int opq_gdim() { int t = (int)gridDim.x; asm volatile("" : "+s"(t)); return t; }
namespace pg8 {
#define PG8_LAS __attribute__((address_space(3)))
typedef unsigned short bf16_t;
typedef short bf16x8 __attribute__((ext_vector_type(8)));
typedef float f32x4 __attribute__((ext_vector_type(4)));
typedef unsigned u32x4 __attribute__((ext_vector_type(4)));
constexpr int BM = 256, BK = 64, HALF = 128, HTB = HALF * BK * 2  , STAGE_BYTES = 8 * HTB, NXCD = 8, WGM = 8;

__host__ __device__ __forceinline__ int lds_byte(int r, int c) { const int st = (r >> 4) * 2 + (c >> 5), rr = r & 15, cc = c & 31, ob = rr * 64 + cc * 2; return st * 1024 + (ob ^ (((ob >> 9) & 1) << 5)); }
__host__ __device__ __forceinline__ void stage_rc(int b, int& R, int& C) { const int st = b / 1024, sb = b % 1024, swz = sb ^ (((sb >> 9) & 1) << 5); R = (st >> 1) * 16 + swz / 64; C = (st & 1) * 32 + (swz % 64) / 2; }
__host__ __device__ __forceinline__ int perm32(int rho) { const int n = rho >> 4, i = rho & 15; return 8 * (i >> 2) + 4 * n + (i & 3); }

struct Unit { int pm, pn; };
struct Gemm { const bf16_t* A; const bf16_t* Bt; int M, N, K; };

struct StaticOrder {
    int nM, nN, nwg, G, c;
    __host__ __device__ void init(int M, int N, int G_, int c_) { nM = M / BM; nN = N / BM; nwg = nM * nN; G = G_; c = c_; }
    __host__ __device__ bool next(int i, Unit& u) const {
        const long L = (long)i * G + c; if (L >= nwg) return false;
        int wgid = (int)L; { const int q = nwg / NXCD, r = nwg % NXCD, xcd = wgid % NXCD, off = wgid / NXCD; wgid = (xcd < r ? xcd * (q + 1) : r * (q + 1) + (xcd - r) * q) + off; }
        const int nig = WGM * nN, gid = wgid / nig, fm = gid * WGM, gsz = (nM - fm) < WGM ? (nM - fm) : WGM;
        u.pm = fm + ((wgid % nig) % gsz); u.pn = (wgid % nig) / gsz; return true;
    }
    __device__ __forceinline__ void a_ready(const Unit&) const {}
    __device__ __forceinline__ void done(const Unit&) const {}
};
__device__ __forceinline__ unsigned cvt_pk_bf16(float lo, float hi) { unsigned r; asm volatile("v_cvt_pk_bf16_f32 %0, %1, %2" : "=v"(r) : "v"(lo), "v"(hi)); return r; }
typedef float f32x2 __attribute__((ext_vector_type(2)));
__device__ __forceinline__ f32x2 gelu_pk(f32x2 v) {
    const f32x2 av = __builtin_elementwise_abs(v), d = av * 0.2316418882f + 1.0f;
    f32x2 t; t.x = __builtin_amdgcn_rcpf(d.x); t.y = __builtin_amdgcn_rcpf(d.y);
    f32x2 q = t * 0.5307027145f + (-0.7265760135f); q = q * t + 0.7107068705f; q = q * t + (-0.142248368f); q = q * t + 0.127414796f; q = q * t;
    const f32x2 s = (v * v) * (-0.72134752044f);
    f32x2 e; e.x = __builtin_amdgcn_exp2f(s.x); e.y = __builtin_amdgcn_exp2f(s.y);
    const f32x2 m = v * (q * e), r = v - m;
    f32x2 o; o.x = v.x < 0.f ? m.x : r.x; o.y = v.y < 0.f ? m.y : r.y; return o;
}

struct EpiF32 {
    static constexpr bool PERM = false, AFTER_DRAIN = false;
    float* C; int ldc; const float* bias;
    __device__ __forceinline__ void operator()(const f32x4 (&acc)[2][2][4][2], const Unit& u, int wr, int wc, int fr, int fq) const {
        const int row0 = u.pm * BM + wr * 64 + fr, col0 = u.pn * BM + wc * 32 + 4 * fq;
        f32x4 bv[2][2];
#pragma unroll
        for (int bj = 0; bj < 2; ++bj)
#pragma unroll
            for (int n = 0; n < 2; ++n) bv[bj][n] = bias ? *(const f32x4*)(bias + col0 + bj * HALF + n * 16) : (f32x4){0.f, 0.f, 0.f, 0.f};
#pragma unroll
        for (int ai = 0; ai < 2; ++ai)
#pragma unroll
            for (int m = 0; m < 4; ++m) { float* rowp = C + (size_t)(row0 + ai * HALF + m * 16) * ldc + col0;
#pragma unroll
                for (int bj = 0; bj < 2; ++bj)
#pragma unroll
                    for (int n = 0; n < 2; ++n) *(f32x4*)(rowp + bj * HALF + n * 16) = acc[ai][bj][m][n] + bv[bj][n]; }
    }
};
template <int ACT  > struct EpiBf16 {
    static constexpr bool PERM = true, AFTER_DRAIN = false;
    bf16_t* O; int ldc; const float* bias; int split_cols; size_t split_stride;
    __device__ __forceinline__ void operator()(const f32x4 (&acc)[2][2][4][2], const Unit& u, int wr, int wc, int fr, int fq) const {
        const int row0 = u.pm * BM + wr * 64 + fr; int colt = u.pn * BM; bf16_t* base = O;
        if (split_cols) { const int t = colt / split_cols; base += (size_t)t * split_stride; colt -= t * split_cols; }
        const int col0 = colt + wc * 32 + 8 * fq, bcol0 = u.pn * BM + wc * 32 + 8 * fq;
        f32x4 bv[2][2];
#pragma unroll
        for (int bj = 0; bj < 2; ++bj)
#pragma unroll
            for (int n = 0; n < 2; ++n) bv[bj][n] = bias ? *(const f32x4*)(bias + bcol0 + bj * HALF + 4 * n) : (f32x4){0.f, 0.f, 0.f, 0.f};
#pragma unroll
        for (int ai = 0; ai < 2; ++ai)
#pragma unroll
            for (int m = 0; m < 4; ++m) { bf16_t* rowp = base + (size_t)(row0 + ai * HALF + m * 16) * ldc + col0;
#pragma unroll
                for (int bj = 0; bj < 2; ++bj) { f32x4 v0 = acc[ai][bj][m][0] + bv[bj][0], v1 = acc[ai][bj][m][1] + bv[bj][1];
                    if (ACT == 1) { f32x2 a = gelu_pk((f32x2){v0[0], v0[1]}), b = gelu_pk((f32x2){v0[2], v0[3]}), c = gelu_pk((f32x2){v1[0], v1[1]}), d = gelu_pk((f32x2){v1[2], v1[3]});
                        v0 = (f32x4){a.x, a.y, b.x, b.y}; v1 = (f32x4){c.x, c.y, d.x, d.y}; }
                    if (ACT == 2) {
#pragma unroll
                        for (int j = 0; j < 4; ++j) { v0[j] = 0.5f * v0[j] * (1.0f + erff(v0[j] * 0.70710678f)); v1[j] = 0.5f * v1[j] * (1.0f + erff(v1[j] * 0.70710678f)); } }
                    u32x4 w; w.x = cvt_pk_bf16(v0[0], v0[1]); w.y = cvt_pk_bf16(v0[2], v0[3]); w.z = cvt_pk_bf16(v1[0], v1[1]); w.w = cvt_pk_bf16(v1[2], v1[3]);
                    *(u32x4*)(rowp + bj * HALF) = w; } }
    }
};

template <class Epi, class Sched, bool STAMP = false>
__device__ __forceinline__ void gemm_phase(PG8_LAS unsigned char* lds, const Gemm g, const Sched& S, const Epi& E, unsigned long long* stamps) {
    const int tid = opq_tid(), wid = __builtin_amdgcn_readfirstlane(tid >> 6), lane = tid & 63, wr = wid >> 2, wc = wid & 3, fr = lane & 15, fq = lane >> 4;
    const int K = g.K, nt = K / BK;
    int ts_lo = 0, ts_hi = 0, nts = 0; const unsigned long long rt_entry = STAMP ? (unsigned long long)wall_clock64() : 0ull;
#define PG8_STAMP() do { if (STAMP && wid == 0 && nts < 64) { const unsigned long long _c = (unsigned long long)clock64(); \
        ts_lo = (lane == nts) ? (int)(unsigned)_c : ts_lo; ts_hi = (lane == nts) ? (int)(unsigned)(_c >> 32) : ts_hi; ++nts; } } while (0)
    PG8_STAMP();
    unsigned voffA[2], voffB[2];
#pragma unroll
    for (int i = 0; i < 2; ++i) { int R, C; stage_rc(tid * 16 + i * 8192, R, C); const int Rb = Epi::PERM ? ((R & ~31) + perm32(R & 31)) : R;
        voffA[i] = (unsigned)(R * K + C) * 2u; voffB[i] = (unsigned)(Rb * K + C) * 2u; }
    const size_t kstep = (size_t)(BK * 2);
    const size_t hstep = (size_t)HALF * K * 2;
    const size_t tstep = 2 * hstep;
    const unsigned ldsw = (unsigned)wid * 1024u;
    const int aoff = lds_byte(wr * 64 + fr, fq * 8), boff = lds_byte(wc * 32 + fr, fq * 8);
#define PG8_SA(b, h) (((b) * 2 + (h)) * HTB)
#define PG8_SB(b, h) ((4 + (b) * 2 + (h)) * HTB)
#define PG8_STAGE(bufoff, gbase, voff) do { _Pragma("unroll") for (int _i = 0; _i < 2; ++_i) \
        __builtin_amdgcn_global_load_lds((const unsigned*)((const char*)(gbase) + (voff)[_i]), (PG8_LAS unsigned*)(lds + (bufoff) + ldsw + _i * 8192), 16, 0, 0); } while (0)
#define PG8_LDA(dst, b, h) do { _Pragma("unroll") for (int m = 0; m < 4; ++m) _Pragma("unroll") for (int k = 0; k < 2; ++k) dst[m][k] = *(const PG8_LAS bf16x8*)(lds + PG8_SA(b, h) + aoff + m * 2048 + k * 1024); } while (0)
#define PG8_LDB(dst, b, h) do { _Pragma("unroll") for (int n = 0; n < 2; ++n) _Pragma("unroll") for (int k = 0; k < 2; ++k) dst[n][k] = *(const PG8_LAS bf16x8*)(lds + PG8_SB(b, h) + boff + n * 2048 + k * 1024); } while (0)
#define PG8_MMA(ai, bj, At, Bt) do { __builtin_amdgcn_s_setprio(1); _Pragma("unroll") for (int m = 0; m < 4; ++m) _Pragma("unroll") for (int n = 0; n < 2; ++n) _Pragma("unroll") for (int k = 0; k < 2; ++k) \
        acc[ai][bj][m][n] = __builtin_amdgcn_mfma_f32_16x16x32_bf16(Bt[n][k], At[m][k], acc[ai][bj][m][n], 0, 0, 0); __builtin_amdgcn_s_setprio(0); } while (0)
#define PG8_WAIT_V(n) asm volatile("s_waitcnt vmcnt(" #n ")" ::: "memory")
#define PG8_WAIT_L(n) asm volatile("s_waitcnt lgkmcnt(" #n ")" ::: "memory")
#define PG8_BAR __builtin_amdgcn_s_barrier()
#define PG8_SCHED __builtin_amdgcn_sched_barrier(0)
    Unit cur, nxt; int ui = 0;
    if (!S.next(0, cur)) return;
    f32x4 acc[2][2][4][2];
#pragma unroll
    for (int a = 0; a < 2; ++a)
#pragma unroll
        for (int b = 0; b < 2; ++b)
#pragma unroll
            for (int m = 0; m < 4; ++m)
#pragma unroll
                for (int n = 0; n < 2; ++n) acc[a][b][m][n] = (f32x4){0.f, 0.f, 0.f, 0.f};
    bf16x8 At[4][2], B0[2][2], B1[2][2];
    const char* cA = (const char*)g.A + (size_t)cur.pm * tstep; const char* cB = (const char*)g.Bt + (size_t)cur.pn * tstep;
    S.a_ready(cur);
    PG8_STAGE(PG8_SB(0, 0), cB, voffB); PG8_STAGE(PG8_SA(0, 0), cA, voffA); PG8_STAGE(PG8_SB(0, 1), cB + hstep, voffB); PG8_STAGE(PG8_SA(0, 1), cA + hstep, voffA);
    if (wr == 1) PG8_BAR;
    PG8_WAIT_V(4); PG8_BAR;
    PG8_STAGE(PG8_SB(1, 0), cB + kstep, voffB); PG8_STAGE(PG8_SA(1, 0), cA + kstep, voffA); PG8_STAGE(PG8_SB(1, 1), cB + hstep + kstep, voffB);
    PG8_WAIT_V(6); PG8_BAR;
    PG8_STAMP();
    for (;;) {
        const bool has_next = S.next(ui + 1, nxt);
        const char* nA = has_next ? (const char*)g.A + (size_t)nxt.pm * tstep : cA; const char* nB = has_next ? (const char*)g.Bt + (size_t)nxt.pn * tstep : cB;
        for (int t = 0; t < nt; t += 2) {
            const bool last = (t == nt - 2);
            const char* a1 = cA + (size_t)(t + 1) * kstep;
            const char* a2 = last ? nA : cA + (size_t)(t + 2) * kstep; const char* b2 = last ? nB : cB + (size_t)(t + 2) * kstep;
            const char* a3 = a2 + kstep; const char* b3 = b2 + kstep;
            if (last && has_next) S.a_ready(nxt);
            PG8_LDB(B0, 0, 0); PG8_SCHED; PG8_LDA(At, 0, 0); PG8_STAGE(PG8_SA(1, 1), a1 + hstep, voffA);
            PG8_WAIT_L(8); PG8_BAR; PG8_WAIT_L(0); PG8_MMA(0, 0, At, B0); PG8_BAR; PG8_SCHED;
            PG8_LDB(B1, 0, 1); PG8_STAGE(PG8_SB(0, 0), b2, voffB);
            PG8_BAR; PG8_WAIT_L(0); PG8_MMA(0, 1, At, B1); PG8_BAR;
            PG8_LDA(At, 0, 1); PG8_STAGE(PG8_SA(0, 0), a2, voffA);
            PG8_BAR; PG8_WAIT_L(0); PG8_MMA(1, 0, At, B0); PG8_BAR; PG8_SCHED;
            PG8_STAGE(PG8_SB(0, 1), b2 + hstep, voffB);
            PG8_WAIT_V(6); PG8_BAR; PG8_MMA(1, 1, At, B1); PG8_BAR;
            PG8_LDB(B0, 1, 0); PG8_SCHED; PG8_LDA(At, 1, 0); PG8_STAGE(PG8_SA(0, 1), a2 + hstep, voffA);
            PG8_WAIT_L(8); PG8_BAR; PG8_WAIT_L(0); PG8_MMA(0, 0, At, B0); PG8_BAR; PG8_SCHED;
            PG8_LDB(B1, 1, 1); PG8_STAGE(PG8_SB(1, 0), b3, voffB);
            PG8_BAR; PG8_WAIT_L(0); PG8_MMA(0, 1, At, B1); PG8_BAR;
            PG8_LDA(At, 1, 1); PG8_STAGE(PG8_SA(1, 0), a3, voffA);
            PG8_BAR; PG8_WAIT_L(0); PG8_MMA(1, 0, At, B0); PG8_BAR; PG8_SCHED;
            PG8_STAGE(PG8_SB(1, 1), b3 + hstep, voffB);
            PG8_WAIT_V(6); PG8_BAR; PG8_MMA(1, 1, At, B1); PG8_BAR;
        }
        PG8_STAMP();
        if constexpr (!Epi::AFTER_DRAIN) { E(acc, cur, wr, wc, fr, fq); S.done(cur); }
        PG8_STAMP();
        if (!has_next) break;
#pragma unroll
        for (int a = 0; a < 2; ++a)
#pragma unroll
            for (int b = 0; b < 2; ++b)
#pragma unroll
                for (int m = 0; m < 4; ++m)
#pragma unroll
                    for (int n = 0; n < 2; ++n) acc[a][b][m][n] = (f32x4){0.f, 0.f, 0.f, 0.f};
        cur = nxt; cA = nA; cB = nB; ++ui;
    }
    PG8_WAIT_V(0);
    if (wr == 0) PG8_BAR;
    PG8_BAR;
    if constexpr (Epi::AFTER_DRAIN) { E.fused(acc, cur, wr, wc, fr, fq, lds, wid, lane); S.done(cur); }
    PG8_STAMP();
    if (STAMP && wid == 0) { stamps[lane] = lane < nts ? (((unsigned long long)(unsigned)ts_hi << 32) | (unsigned)ts_lo) : 0ull;
        if (lane == 62) stamps[62] = rt_entry; if (lane == 63) stamps[63] = (unsigned long long)wall_clock64(); }
#undef PG8_STAMP
#undef PG8_SA
#undef PG8_SB
#undef PG8_STAGE
#undef PG8_LDA
#undef PG8_LDB
#undef PG8_MMA
#undef PG8_WAIT_V
#undef PG8_WAIT_L
#undef PG8_BAR
#undef PG8_SCHED
}
}
namespace da {
constexpr int D = 128;
constexpr int LDI = 7168, LDO = 2048;
constexpr float THR = 8.f;
constexpr bool WSKIP = false;
constexpr float SCALE = 0.08838834764831845f;
constexpr int NW = 8, QBLK = 32, KVBLK = 64, QB = NW * QBLK;
constexpr int SHM_V = KVBLK * D * 2, SHM_K = KVBLK * D * 2;
constexpr int LDS_BYTES = 2 * SHM_V + 2 * SHM_K + NW * 64 * 4;

using bf16 = __hip_bfloat16;
typedef short bf16x8 __attribute__((ext_vector_type(8)));
typedef short s16x4 __attribute__((ext_vector_type(4)));
typedef float f32x16 __attribute__((ext_vector_type(16)));
typedef float f32x4 __attribute__((ext_vector_type(4)));
typedef unsigned u32x4 __attribute__((ext_vector_type(4)));
template <class A, class Bt> struct same_t { static constexpr bool v = false; };
template <class A> struct same_t<A, A> { static constexpr bool v = true; };

#define KSWZ(row, colB) ((row) * 256 + ((colB) ^ (((row) & 7) << 4)))
#define SBAR() __builtin_amdgcn_sched_barrier(0)
__device__ __forceinline__ int v_st(int k, int c) { const int kk = (k & ~0xC) | ((k & 4) << 1) | ((k & 8) >> 1); return ((kk >> 3) * 4 + (c >> 5)) * 512 + ((kk & 7) * 32 + (c & 31)) * 2; }
__device__ __forceinline__ int v_rd_base(int lane) { return ((lane & 3) << 3) | (((lane >> 2) & 3) << 6) | (((lane >> 4) & 1) << 5) | (((lane >> 5) & 1) << 8); }
constexpr int v_rd_off(int d0, int ks, int half) { return d0 * 512 + ks * 4096 + half * 2048; }
__device__ __forceinline__ int crow(int r, int hi) { return (r & 3) + 8 * (r >> 2) + 4 * hi; }
__device__ __forceinline__ unsigned cvtpk(float lo, float hi) {
    unsigned r; asm volatile("v_cvt_pk_bf16_f32 %0, %1, %2" : "=v"(r) : "v"(lo), "v"(hi)); return r;
}
__device__ __forceinline__ bf16x8 pack8(f32x4 a, f32x4 b) {
    u32x4 w = {cvtpk(a[0], a[1]), cvtpk(a[2], a[3]), cvtpk(b[0], b[1]), cvtpk(b[2], b[3])};
    return *reinterpret_cast<bf16x8*>(&w);
}
template <class T> __device__ __forceinline__ bf16x8 load8(const T* p) {
    if constexpr (same_t<T, float>::v) { return pack8(*(const f32x4*)p, *(const f32x4*)(p + 4)); }
    else { return *reinterpret_cast<const bf16x8*>(p); }
}
__device__ __forceinline__ void mask_tile(f32x16& p0, f32x16& p1, int dq, unsigned W) {
    const float NEG = -__builtin_inff();
#pragma unroll
    for (int r = 0; r < 16; ++r) {
        const int c = (r & 3) + 8 * (r >> 2);
        if ((unsigned)(dq - c) >= W) p0[r] = NEG;
        if ((unsigned)(dq - c - 32) >= W) p1[r] = NEG;
    }
}
__device__ __forceinline__ void partialSM(f32x16& p0, f32x16& p1, float& m_reg, float& mn, float& alpha) {
    float pmax = p0[0]; for (int r = 1; r < 16; ++r) pmax = fmaxf(pmax, p0[r]); for (int r = 0; r < 16; ++r) pmax = fmaxf(pmax, p1[r]);
    { auto rr = __builtin_amdgcn_permlane32_swap(__float_as_uint(pmax), __float_as_uint(pmax), false, false);
      pmax = fmaxf(__uint_as_float(rr[0]), __uint_as_float(rr[1])); }
    constexpr float C2 = 1.4426950408889634f * SCALE;
    if (__builtin_expect(__all((pmax - m_reg) * SCALE <= THR), 1)) { mn = m_reg; alpha = 1.f; }
    else { mn = fmaxf(m_reg, pmax); alpha = __builtin_amdgcn_exp2f((m_reg - mn) * C2); m_reg = mn; }
    const float mnL = -mn * C2;
    for (int r = 0; r < 16; ++r) p0[r] = fmaf(p0[r], C2, mnL); for (int r = 0; r < 16; ++r) p1[r] = fmaf(p1[r], C2, mnL);
    for (int r = 0; r < 16; ++r) p0[r] = __builtin_amdgcn_exp2f(p0[r]);
}
__device__ __forceinline__ void finishSM(f32x16& p0, f32x16& p1, float alpha, float& l_reg, bf16x8& pa0, bf16x8& pa1, bf16x8& pa2, bf16x8& pa3) {
    for (int r = 0; r < 16; ++r) p1[r] = __builtin_amdgcn_exp2f(p1[r]);
    float ps = 0; for (int r = 0; r < 16; ++r) ps += p0[r]; for (int r = 0; r < 16; ++r) ps += p1[r];
    { auto rr = __builtin_amdgcn_permlane32_swap(__float_as_uint(ps), __float_as_uint(ps), false, false);
      ps = __uint_as_float(rr[0]) + __uint_as_float(rr[1]); }
    l_reg = l_reg * alpha + ps;
#define PK4(P, B_, OUT) do { unsigned a0 = cvtpk(P[B_+0], P[B_+1]), a1 = cvtpk(P[B_+2], P[B_+3]);                          \
        unsigned b0 = cvtpk(P[B_+4], P[B_+5]), b1 = cvtpk(P[B_+6], P[B_+7]);                                             \
        auto r0 = __builtin_amdgcn_permlane32_swap(a0, b0, false, false); auto r1 = __builtin_amdgcn_permlane32_swap(a1, b1, false, false); \
        u32x4 w = {r0[0], r1[0], r0[1], r1[1]}; OUT = *reinterpret_cast<bf16x8*>(&w); } while (0)
    PK4(p0, 0, pa0); PK4(p0, 8, pa1); PK4(p1, 0, pa2); PK4(p1, 8, pa3);
#undef PK4
}
template <int KB, bool SK>
__device__ __forceinline__ void qkt(f32x16& p0, f32x16& p1, const char* K_lds, int r32, int hi, const bf16x8* qr, bool act) {
    if (SK && !act) { const float NEG = -__builtin_inff();
#pragma unroll
        for (int r = 0; r < 16; ++r) { p0[r] = NEG; p1[r] = NEG; } return; }
    p0 = f32x16{}; p1 = f32x16{};
    const char* kb[4];
#pragma unroll
    for (int dd = 0; dd < 4; ++dd) kb[dd] = K_lds + KB * SHM_K + KSWZ(r32, (dd * 16 + hi * 8) * 2);
#pragma unroll
    for (int d0 = 0; d0 < 8; ++d0) { const char* a = kb[d0 & 3] + (d0 >> 2) * 128;
        bf16x8 b0 = *reinterpret_cast<const bf16x8*>(a);
        bf16x8 b1 = *reinterpret_cast<const bf16x8*>(a + 32 * 256);
        p0 = __builtin_amdgcn_mfma_f32_32x32x16_bf16(b0, qr[d0], p0, 0, 0, 0);
        p1 = __builtin_amdgcn_mfma_f32_32x32x16_bf16(b1, qr[d0], p1, 0, 0, 0); }
}
template <int VB, bool SK>
__device__ __forceinline__ void pv_tile(f32x16* o, int vb0, bf16x8 pa0, bf16x8 pa1, bf16x8 pa2, bf16x8 pa3, bool act) {
    if (SK && !act) return;
#define TRRD(dst, off) asm volatile("ds_read_b64_tr_b16 %0, %1 offset:%2" : "=&v"(dst) : "v"(vb0), "i"(off) : "memory")
#define PV_D0(d0) do { s16x4 l0, l1, l2, l3, h0, h1, h2, h3; constexpr int b_ = VB * SHM_V + v_rd_off(d0, 0, 0);     \
        TRRD(l0, b_); TRRD(h0, b_ + 2048); TRRD(l1, b_ + 4096); TRRD(h1, b_ + 6144); TRRD(l2, b_ + 8192); TRRD(h2, b_ + 10240); TRRD(l3, b_ + 12288); TRRD(h3, b_ + 14336); \
        asm volatile("s_waitcnt lgkmcnt(0)" ::: "memory"); SBAR();                 \
        o[d0] = __builtin_amdgcn_mfma_f32_32x32x16_bf16(pa0, (bf16x8){l0[0], l0[1], l0[2], l0[3], h0[0], h0[1], h0[2], h0[3]}, o[d0], 0, 0, 0);   \
        o[d0] = __builtin_amdgcn_mfma_f32_32x32x16_bf16(pa1, (bf16x8){l1[0], l1[1], l1[2], l1[3], h1[0], h1[1], h1[2], h1[3]}, o[d0], 0, 0, 0);   \
        o[d0] = __builtin_amdgcn_mfma_f32_32x32x16_bf16(pa2, (bf16x8){l2[0], l2[1], l2[2], l2[3], h2[0], h2[1], h2[2], h2[3]}, o[d0], 0, 0, 0);   \
        o[d0] = __builtin_amdgcn_mfma_f32_32x32x16_bf16(pa3, (bf16x8){l3[0], l3[1], l3[2], l3[3], h3[0], h3[1], h3[2], h3[3]}, o[d0], 0, 0, 0); } while (0)
    PV_D0(0); PV_D0(1); PV_D0(2); PV_D0(3);
#undef PV_D0
#undef TRRD
}

template <class TIn, class TOut> struct BlockRef { const TIn* Q; const TIn* K; const TIn* V; TOut* O; int P0; };
template <class TIn> struct Seam {
    bf16x8 qr[8];
    bf16x8 st_v0, st_v1, st_k0, st_k1; f32x4 sf0, sf1, sf2, sf3;
    f32x4 tq[16];
};
__device__ __forceinline__ int swa_jlo(int P0, int W) { const int lowk = P0 - W + 1; return lowk > 0 ? lowk / KVBLK : 0; }
#define ROW(p, k0, rr) ((p) + (size_t)((k0) + (rr)) * LDI + sc)
#define VMW() asm volatile("s_waitcnt vmcnt(0)" ::: "memory")
#define VMWN(n) asm volatile("s_waitcnt vmcnt(%0)" :: "i"(n) : "memory")
#define SLOAD_H(Kp, Vp, k0) do { S.st_v0 = load8<TIn>(ROW(Vp, k0, sr)); S.st_v1 = load8<TIn>(ROW(Vp, k0, 32 + sr));              \
                         S.st_k0 = load8<TIn>(ROW(Kp, k0, sr)); S.st_k1 = load8<TIn>(ROW(Kp, k0, 32 + sr)); } while (0)
#define SWRITE_HK(bf) do { *(bf16x8*)(K_lds + (bf) * SHM_K + kws) = S.st_k0; *(bf16x8*)(K_lds + (bf) * SHM_K + kws + 32 * 256) = S.st_k1; } while (0)
#define SWRITE_HV(bf) do { *(bf16x8*)(V_lds + (bf) * SHM_V + vst0) = S.st_v0; *(bf16x8*)(V_lds + (bf) * SHM_V + vst1) = S.st_v1; } while (0)
#define SWRITE_H(bf) do { SWRITE_HV(bf); SWRITE_HK(bf); } while (0)
#define SLOAD_F(p, k0) do { S.sf0 = *(const f32x4*)ROW(p, k0, sr); S.sf1 = *(const f32x4*)(ROW(p, k0, sr) + 4);                \
                            S.sf2 = *(const f32x4*)ROW(p, k0, 32 + sr); S.sf3 = *(const f32x4*)(ROW(p, k0, 32 + sr) + 4); } while (0)
#define SWRITE_KF(bf) do { *(bf16x8*)(K_lds + (bf) * SHM_K + kws) = pack8(S.sf0, S.sf1); *(bf16x8*)(K_lds + (bf) * SHM_K + kws + 32 * 256) = pack8(S.sf2, S.sf3); } while (0)
#define SWRITE_VF(bf) do { *(bf16x8*)(V_lds + (bf) * SHM_V + vst0) = pack8(S.sf0, S.sf1); *(bf16x8*)(V_lds + (bf) * SHM_V + vst1) = pack8(S.sf2, S.sf3); } while (0)
template <class TIn, class TOut>
__device__ __forceinline__ void causal_swa_prime(const BlockRef<TIn, TOut>& cur, int W, char* lds, Seam<TIn>& S) {
    constexpr bool F32 = same_t<TIn, float>::v;
    const int tid = opq_tid(), wid = __builtin_amdgcn_readfirstlane(tid >> 6), lane = tid & 63, r32 = lane & 31, hi = lane >> 5;
    const int sr = tid >> 4, sc = (tid & 15) * 8, kws = KSWZ(sr, sc * 2); char* K_lds = lds + 2 * SHM_V;
    const int kb0 = swa_jlo(cur.P0, W) * KVBLK;
    for (int d0 = 0; d0 < 8; ++d0) S.qr[d0] = load8<TIn>(cur.Q + (size_t)(wid * QBLK + r32) * LDI + d0 * 16 + hi * 8);
    if constexpr (F32) { SLOAD_F((const float*)cur.K, kb0); VMW(); SWRITE_KF(0); SBAR(); SLOAD_F((const float*)cur.V, kb0); }
    else { SLOAD_H(cur.K, cur.V, kb0); VMW(); SWRITE_HK(0); }
    __syncthreads();
}
template <class TIn, class TOut>
__device__ __forceinline__ void causal_swa_block(const BlockRef<TIn, TOut>& cur, const BlockRef<TIn, TOut>& nxt, int skv, int W, char* lds, Seam<TIn>& S) {
    constexpr bool F32 = same_t<TIn, float>::v;
    const int tid = opq_tid(), wid = __builtin_amdgcn_readfirstlane(tid >> 6), lane = tid & 63, r32 = lane & 31, hi = lane >> 5;
    const int j_lo = swa_jlo(cur.P0, W);
    int j_hi = (cur.P0 + QB - 1) / KVBLK + 1; if (j_hi > skv / KVBLK) j_hi = skv / KVBLK;
    const int NT = j_hi - j_lo;
    const int kbn = swa_jlo(nxt.P0, W) * KVBLK;
    const int qlo = cur.P0 + wid * QBLK, qm = qlo + r32 - 4 * hi;
    char* V_lds = lds; char* K_lds = lds + 2 * SHM_V;
    float* ws = (float*)(lds + 2 * SHM_V + 2 * SHM_K) + wid * 64; float* li_l = ws, * al_l = ws + 32;
    float m_reg = -1e30f, l_reg = 0; f32x16 o[4] = {};
    const int sr = tid >> 4, sc = (tid & 15) * 8, vst0 = v_st(sr, sc), vst1 = v_st(32 + sr, sc), kws = KSWZ(sr, sc * 2);
    const int vb0 = (int)(uintptr_t)V_lds + v_rd_base(lane);
    const TIn* Kh = cur.K; const TIn* Vh = cur.V;
#define RESC(a) do { if (__any((a) < 1.f)) { if (hi == 0) al_l[r32] = (a); asm volatile("s_waitcnt lgkmcnt(0)" ::: "memory");              \
                     for (int d_ = 0; d_ < 4; ++d_) for (int r = 0; r < 16; ++r) o[d_][r] *= al_l[crow(r, hi)]; } } while (0)
#define KBASE(t) ((j_lo + (t)) * KVBLK)
#define ACT(t) (KBASE(t) <= qlo + QBLK - 1 && KBASE(t) + KVBLK - 1 >= qlo - W + 1)
#define MASKT(P0_, P1_, t) do { const int kb_ = KBASE(t); if ((!SK || ACT(t)) && (kb_ + KVBLK - 1 > qlo || kb_ <= qlo + QBLK - 1 - W)) mask_tile(P0_, P1_, qm - kb_, (unsigned)W); } while (0)
    constexpr int NQL = F32 ? 16 : 8;
    constexpr bool SK = WSKIP && !F32;
#define SEAM_K0() do { VMWN(NQL); if constexpr (F32) { SWRITE_KF(0); SBAR(); SLOAD_F((const float*)nxt.V, kbn); } else { SWRITE_HK(0); } SBAR(); } while (0)
    f32x16 pA0, pA1, pB0, pB1; float mnA, mnB, alA, alB; bf16x8 pa0, pa1, pa2, pa3;
    if constexpr (F32) { VMW(); SWRITE_VF(0); SBAR(); } else { SWRITE_HV(0); SBAR(); }
    if (NT > 1) { if constexpr (F32) SLOAD_F((const float*)Kh, KBASE(1)); else SLOAD_H(Kh, Vh, KBASE(1)); }
    SBAR(); qkt<0, SK>(pA0, pA1, K_lds, r32, hi, S.qr, ACT(0));
    if constexpr (F32) { if (NT > 1) { VMW(); SWRITE_KF(1); SBAR(); SLOAD_F((const float*)Vh, KBASE(1)); } }
    MASKT(pA0, pA1, 0); partialSM(pA0, pA1, m_reg, mnA, alA);
    if (NT > 1) { VMW(); if constexpr (F32) { SWRITE_VF(1); SBAR(); if (NT > 2) SLOAD_F((const float*)Kh, KBASE(2)); } else SWRITE_H(1); }
    __syncthreads();
#define HALF_STEP(PX0, PX1, mnX, alX, PY0, PY1, alY, t, KB, VB, SB) do {                                                      \
        SBAR(); qkt<KB, SK>(PX0, PX1, K_lds, r32, hi, S.qr, ACT(t));                                             \
        finishSM(PY0, PY1, alY, l_reg, pa0, pa1, pa2, pa3); SBAR();                                                           \
        if ((t) + 1 < NT) { if constexpr (F32) { VMW(); SWRITE_KF(SB); SBAR(); SLOAD_F((const float*)Vh, KBASE((t) + 1)); }  \
                            else { SLOAD_H(Kh, Vh, KBASE((t) + 1)); } SBAR(); }                                               \
        pv_tile<VB, SK>(o, vb0, pa0, pa1, pa2, pa3, ACT((t) - 1)); MASKT(PX0, PX1, (t)); partialSM(PX0, PX1, m_reg, mnX, alX);                                        \
        __syncthreads();                                                                                                      \
        if ((t) + 1 < NT) { VMW(); if constexpr (F32) { SWRITE_VF(SB); SBAR(); if ((t) + 2 < NT) SLOAD_F((const float*)Kh, KBASE((t) + 2)); } \
                            else { SWRITE_H(SB); } }                                                                          \
        RESC(alX); __syncthreads(); } while (0)
    for (int t = 1; t + 1 < NT; t += 2) {
        HALF_STEP(pB0, pB1, mnB, alB, pA0, pA1, alA, t, 1, 0, 0);
        HALF_STEP(pA0, pA1, mnA, alA, pB0, pB1, alB, t + 1, 0, 1, 1);
    }
    const bool even = (NT & 1) == 0;
    if (even) { SBAR(); qkt<1, SK>(pB0, pB1, K_lds, r32, hi, S.qr, ACT(NT - 1)); SBAR(); }
#define QROW(e) (nxt.Q + (size_t)(wid * QBLK + r32) * LDI + ((e) >> 1) * 16 + hi * 8 + ((e) & 1) * 4)
    if constexpr (F32) { SLOAD_F((const float*)nxt.K, kbn); SBAR();
#pragma unroll
        for (int e = 0; e < 8; ++e) S.tq[e] = *(const f32x4*)QROW(e); }
    else { SLOAD_H(nxt.K, nxt.V, kbn); SBAR();
#pragma unroll
        for (int d0 = 0; d0 < 8; ++d0) S.qr[d0] = load8<TIn>(nxt.Q + (size_t)(wid * QBLK + r32) * LDI + d0 * 16 + hi * 8); }
    SBAR();
    finishSM(pA0, pA1, alA, l_reg, pa0, pa1, pa2, pa3); SBAR();
    if constexpr (F32) {
#pragma unroll
        for (int e = 8; e < 16; ++e) S.tq[e] = *(const f32x4*)QROW(e); SBAR(); }
#undef QROW
    pv_tile<0, SK>(o, vb0, pa0, pa1, pa2, pa3, ACT(even ? NT - 2 : NT - 1));
    if (even) { MASKT(pB0, pB1, NT - 1); partialSM(pB0, pB1, m_reg, mnB, alB); __syncthreads(); RESC(alB);
        finishSM(pB0, pB1, alB, l_reg, pa0, pa1, pa2, pa3); SBAR(); pv_tile<1, SK>(o, vb0, pa0, pa1, pa2, pa3, ACT(NT - 1)); }
    SBAR(); SEAM_K0();
    if (hi == 0) li_l[r32] = l_reg; asm volatile("s_waitcnt lgkmcnt(0)" ::: "memory");
    float rli[16];
#pragma unroll
    for (int r = 0; r < 16; ++r) rli[r] = __builtin_amdgcn_rcpf(li_l[crow(r, hi)]);
    TOut* Ow = cur.O + (size_t)(wid * QBLK) * LDO;
#pragma unroll
    for (int r = 0; r < 16; ++r) { const int orow = crow(r, hi);
#pragma unroll
        for (int d0 = 0; d0 < 4; ++d0) { const float v = o[d0][r] * rli[r];
            if constexpr (same_t<TOut, float>::v) { Ow[(size_t)orow * LDO + d0 * 32 + r32] = v; }
            else { const float vn = __shfl_xor(v, 1);
                   if ((r32 & 1) == 0) *(unsigned*)(Ow + (size_t)orow * LDO + d0 * 32 + r32) = cvtpk(v, vn); } } }
    if constexpr (F32) {
#pragma unroll
        for (int d0 = 0; d0 < 8; ++d0) S.qr[d0] = pack8(S.tq[2 * d0], S.tq[2 * d0 + 1]); }
    __syncthreads();
#undef RESC
#undef KBASE
#undef ACT
#undef MASKT
#undef SEAM_K0
#undef HALF_STEP
}
#undef ROW
#undef VMW
#undef VMWN
#undef SLOAD_H
#undef SWRITE_HK
#undef SWRITE_HV
#undef SWRITE_H
#undef SLOAD_F
#undef SWRITE_KF
#undef SWRITE_VF
}

typedef unsigned short u16;
typedef short bf16x8_t __attribute__((ext_vector_type(8)));
typedef float f32x4_t __attribute__((ext_vector_type(4)));
typedef unsigned u32x4_t __attribute__((ext_vector_type(4)));

constexpr int T_ = 16384, S_ = 4096, DM = 2048, DFF = 5504, NGU = 11008, NPJ = 7168, PW = 7176;
constexpr int NTHR = 512;
constexpr int LDT = 130;

constexpr size_t OFF_TAB = 0;
constexpr size_t SZ_TAB = (size_t)4096 * 64 * 4 * 2 + (size_t)4096 * 16 * 4 * 2;
constexpr size_t OFF_WGU1 = OFF_TAB + SZ_TAB;
constexpr size_t SZ_WGU = (size_t)NGU * DM * 2;
constexpr size_t OFF_WD1 = OFF_WGU1 + SZ_WGU;
constexpr size_t SZ_WD = (size_t)DM * DFF * 2;
constexpr size_t OFF_WIN = OFF_WD1 + SZ_WD;
constexpr size_t SZ_WIN = (size_t)NPJ * DM * 2;
constexpr size_t OFF_WOUT = OFF_WIN + SZ_WIN;
constexpr size_t SZ_WOUT = (size_t)DM * DM * 2;
constexpr size_t OFF_WGU2 = OFF_WOUT + SZ_WOUT;
constexpr size_t OFF_WD2 = OFF_WGU2 + SZ_WGU;
constexpr size_t OFF_XB = OFF_WD2 + SZ_WD;
constexpr size_t SZ_XB = (size_t)T_ * DM * 2;
constexpr size_t OFF_HP = OFF_XB + SZ_XB;
constexpr size_t SZ_HP = (size_t)T_ * NPJ * 2;
constexpr size_t OFF_Z = OFF_HP + SZ_HP;
constexpr size_t SZ_Z = (size_t)T_ * DM * 4;
constexpr size_t OFF_GATE = OFF_Z + SZ_Z;
constexpr size_t SZ_GATE = (size_t)T_ * 8 * 4;
constexpr size_t OFF_MQK = OFF_GATE + SZ_GATE;
constexpr size_t SZ_MQK = (size_t)T_ * 1024 * 2;
constexpr size_t OFF_STR = OFF_MQK + SZ_MQK;
constexpr size_t SZ_STR = (size_t)16 * 32 * 16384 * 4;
constexpr size_t OFF_STM = OFF_STR + SZ_STR;
constexpr size_t SZ_STM = (size_t)16 * 64 * 16384 * 4;
constexpr size_t OFF_NM = OFF_STM + SZ_STM;
constexpr size_t SZ_NM = (size_t)16 * 64 * 128 * 4;
constexpr size_t OFF_SC = OFF_NM + SZ_NM;
constexpr size_t SZ_SC = (size_t)16 * 64 * 4 * 4;
constexpr size_t WS_END = OFF_SC + SZ_SC;

constexpr int LDS_TOTAL = 4 * 128 * LDT * 2 + 7 * 128 * 4;

struct Params { const float* in[16]; float* out; unsigned char* ws; };

__device__ __forceinline__ u16 f2bf(float f) { unsigned u = __float_as_uint(f); u += 0x7FFFu + ((u >> 16) & 1u); return (u16)(u >> 16); }
__device__ __forceinline__ float bf2f(u16 b) { return __uint_as_float(((unsigned)b) << 16); }
__device__ __forceinline__ unsigned pk2(float a, float b) { return (unsigned)f2bf(a) | ((unsigned)f2bf(b) << 16); }
__device__ __forceinline__ float wave_sum(float v) {
#pragma unroll
    for (int o = 32; o > 0; o >>= 1) v += __shfl_xor(v, o);
    return v;
}
__device__ __forceinline__ float wave_max(float v) {
#pragma unroll
    for (int o = 32; o > 0; o >>= 1) v = fmaxf(v, __shfl_xor(v, o));
    return v;
}
__device__ __forceinline__ float scan_sum(float v, int lane) {
#pragma unroll
    for (int o = 1; o < 64; o <<= 1) { const float t = __shfl_up(v, o); if (lane >= o) v += t; }
    return v;
}
__device__ __forceinline__ float scan_max(float v, int lane) {
#pragma unroll
    for (int o = 1; o < 64; o <<= 1) { const float t = __shfl_up(v, o); if (lane >= o) v = fmaxf(v, t); }
    return v;
}
__device__ __forceinline__ float silu_f(float x) { return x / (1.0f + __expf(-x)); }
__device__ __forceinline__ float sigmoid_f(float x) { return 1.0f / (1.0f + __expf(-x)); }
__device__ __forceinline__ float logsig_f(float x) { return x >= 0.f ? -log1pf(expf(-x)) : x - log1pf(expf(x)); }

__device__ __forceinline__ void phase_init(const Params& p) {
    const int gtid = opq_bid() * NTHR + opq_tid(), gn = opq_gdim() * NTHR;
    float* retc = (float*)(p.ws + OFF_TAB); float* rets = retc + 4096 * 64; float* difc = rets + 4096 * 64; float* difs = difc + 4096 * 16;
    for (int i = gtid; i < 4096 * 64; i += gn) {
        const int pos = i >> 6, j = i & 63; const float inv = powf(10000.0f, -(float)(2 * j) / 128.0f); const float ang = (float)pos * inv;
        retc[i] = cosf(ang); rets[i] = sinf(ang); }
    for (int i = gtid; i < 4096 * 16; i += gn) {
        const int pos = i >> 4, j = i & 15; const float inv = powf(500000.0f, -(float)(2 * j) / 32.0f); const float ang = (float)pos * inv;
        difc[i] = cosf(ang); difs[i] = sinf(ang); }
    const float4* x4 = (const float4*)p.in[0]; float4* X4 = (float4*)p.out; uint2* xb = (uint2*)(p.ws + OFF_XB);
    for (int i = gtid; i < T_ * DM / 4; i += gn) { const float4 v = x4[i]; X4[i] = v; uint2 w; w.x = pk2(v.x, v.y); w.y = pk2(v.z, v.w); xb[i] = w; }
}

template <int MODE>
__device__ __forceinline__ void convert_T(const float* __restrict__ W, int K, int ldn, int ncols, u16* __restrict__ Wt, float* tile) {
    const int tk = K / 64, tn = ncols / 64, nt = tk * tn, t = opq_tid();
    for (int ti = opq_bid(); ti < nt; ti += opq_gdim()) {
        const int k0 = (ti % tk) * 64, n0 = (ti / tk) * 64;
        __syncthreads();
#pragma unroll
        for (int i = 0; i < 8; ++i) { const int kk = (t >> 6) + 8 * i, nn = t & 63; tile[kk * 65 + nn] = W[(size_t)(k0 + kk) * ldn + n0 + nn]; }
        __syncthreads();
        const int nn = t >> 3, k8 = (t & 7) * 8;
        uint4 w;
        w.x = pk2(tile[(k8 + 0) * 65 + nn], tile[(k8 + 1) * 65 + nn]); w.y = pk2(tile[(k8 + 2) * 65 + nn], tile[(k8 + 3) * 65 + nn]);
        w.z = pk2(tile[(k8 + 4) * 65 + nn], tile[(k8 + 5) * 65 + nn]); w.w = pk2(tile[(k8 + 6) * 65 + nn], tile[(k8 + 7) * 65 + nn]);
        const int n = n0 + nn;
        const int row = MODE == 0 ? n : (256 * ((n % DFF) / 128) + 128 * (n / DFF) + (n % 128));
        *(uint4*)(Wt + (size_t)row * K + k0 + k8) = w;
    }
}
__device__ __forceinline__ void phase_weights(const Params& p, int l, unsigned char* lds) {
    float* tile = (float*)lds;
    convert_T<1>(p.in[3] + (size_t)l * DM * NGU, DM, NGU, NGU, (u16*)(p.ws + OFF_WGU1), tile);
    convert_T<0>(p.in[4] + (size_t)l * DFF * DM, DFF, DM, DM, (u16*)(p.ws + OFF_WD1), tile);
    convert_T<0>(p.in[5] + (size_t)l * DM * PW, DM, PW, NPJ, (u16*)(p.ws + OFF_WIN), tile);
    convert_T<0>(p.in[13] + (size_t)l * DM * DM, DM, DM, DM, (u16*)(p.ws + OFF_WOUT), tile);
    convert_T<1>(p.in[14] + (size_t)l * DM * NGU, DM, NGU, NGU, (u16*)(p.ws + OFF_WGU2), tile);
    convert_T<0>(p.in[15] + (size_t)l * DFF * DM, DFF, DM, DM, (u16*)(p.ws + OFF_WD2), tile);
}

struct EpiSwiGLU {
    static constexpr bool PERM = true, AFTER_DRAIN = false;
    u16* H;
    __device__ __forceinline__ void operator()(const pg8::f32x4 (&acc)[2][2][4][2], const pg8::Unit& u, int wr, int wc, int fr, int fq) const {
        const int row0 = u.pm * 256 + wr * 64 + fr, col0 = u.pn * 128 + wc * 32 + 8 * fq;
#pragma unroll
        for (int ai = 0; ai < 2; ++ai)
#pragma unroll
            for (int m = 0; m < 4; ++m) {
                u16* rowp = H + (size_t)(row0 + ai * 128 + m * 16) * DFF + col0;
                const pg8::f32x4 g0 = acc[ai][0][m][0], g1 = acc[ai][0][m][1], u0 = acc[ai][1][m][0], u1 = acc[ai][1][m][1];
                float h[8];
#pragma unroll
                for (int j = 0; j < 4; ++j) { h[j] = silu_f(g0[j]) * u0[j]; h[4 + j] = silu_f(g1[j]) * u1[j]; }
                pg8::u32x4 w; w.x = pg8::cvt_pk_bf16(h[0], h[1]); w.y = pg8::cvt_pk_bf16(h[2], h[3]); w.z = pg8::cvt_pk_bf16(h[4], h[5]); w.w = pg8::cvt_pk_bf16(h[6], h[7]);
                *(pg8::u32x4*)rowp = w;
            }
    }
};
struct EpiResid {
    static constexpr bool PERM = false, AFTER_DRAIN = false;
    const float* X; float* Z; float alpha, s;
    __device__ __forceinline__ void operator()(const pg8::f32x4 (&acc)[2][2][4][2], const pg8::Unit& u, int wr, int wc, int fr, int fq) const {
        const int row0 = u.pm * 256 + wr * 64 + fr, col0 = u.pn * 256 + wc * 32 + 4 * fq;
#pragma unroll
        for (int ai = 0; ai < 2; ++ai)
#pragma unroll
            for (int m = 0; m < 4; ++m) {
                const size_t off = (size_t)(row0 + ai * 128 + m * 16) * DM + col0;
#pragma unroll
                for (int bj = 0; bj < 2; ++bj)
#pragma unroll
                    for (int n = 0; n < 2; ++n) {
                        const pg8::f32x4 xv = *(const pg8::f32x4*)(X + off + bj * 128 + n * 16);
                        *(pg8::f32x4*)(Z + off + bj * 128 + n * 16) = xv * alpha + acc[ai][bj][m][n] * s; }
            }
    }
};
template <class Epi>
__device__ __forceinline__ void run_gemm(unsigned char* lds, const u16* A, const u16* Bt, int M, int N, int K, const Epi& E) {
    pg8::Gemm g; g.A = A; g.Bt = Bt; g.M = M; g.N = N; g.K = K;
    pg8::StaticOrder S; S.init(M, N, opq_gdim(), opq_bid());
    pg8::gemm_phase<Epi, pg8::StaticOrder, false>((PG8_LAS unsigned char*)lds, g, S, E, nullptr);
}

template <bool GATES>
__device__ __forceinline__ void phase_ln(const float* __restrict__ Z, const float* __restrict__ g, const float* __restrict__ b, float* __restrict__ X, u16* __restrict__ xb,
                         const float* __restrict__ w_in_l, const float* __restrict__ gate_b, float* __restrict__ gates, float* ldsf) {
    const int tid = opq_tid(), wid = tid >> 6, lane = tid & 63;
    if (GATES) {
        __syncthreads();
        for (int i = tid; i < 2048 * 8; i += NTHR) { const int k = i >> 3, j = i & 7; ldsf[j * 2048 + k] = w_in_l[(size_t)k * PW + NPJ + j]; }
        __syncthreads();
    }
    for (int row = opq_bid() * 8 + wid; row < T_; row += opq_gdim() * 8) {
        const float4* zr = (const float4*)(Z + (size_t)row * DM);
        float4 v[8]; float s = 0.f;
#pragma unroll
        for (int i = 0; i < 8; ++i) { v[i] = zr[lane + 64 * i]; s += (v[i].x + v[i].y) + (v[i].z + v[i].w); }
        s = wave_sum(s); const float mean = s * (1.0f / 2048.0f);
        float q = 0.f;
#pragma unroll
        for (int i = 0; i < 8; ++i) { const float a0 = v[i].x - mean, a1 = v[i].y - mean, a2 = v[i].z - mean, a3 = v[i].w - mean; q += (a0 * a0 + a1 * a1) + (a2 * a2 + a3 * a3); }
        q = wave_sum(q); const float rstd = 1.0f / sqrtf(q * (1.0f / 2048.0f) + 1e-5f);
#pragma unroll
        for (int i = 0; i < 8; ++i) {
            const int c4 = lane + 64 * i;
            const float4 gv = ((const float4*)g)[c4], bv = ((const float4*)b)[c4];
            float4 y; y.x = (v[i].x - mean) * rstd * gv.x + bv.x; y.y = (v[i].y - mean) * rstd * gv.y + bv.y; y.z = (v[i].z - mean) * rstd * gv.z + bv.z; y.w = (v[i].w - mean) * rstd * gv.w + bv.w;
            ((float4*)(X + (size_t)row * DM))[c4] = y;
            uint2 w; w.x = pk2(y.x, y.y); w.y = pk2(y.z, y.w); ((uint2*)(xb + (size_t)row * DM))[c4] = w;
            v[i] = y;
        }
        if (GATES) {
#pragma unroll 1
            for (int j = 0; j < 8; ++j) {
                float a = 0.f;
#pragma unroll
                for (int i = 0; i < 8; ++i) { const float4 wv = ((const float4*)(ldsf + j * 2048))[lane + 64 * i]; a += (v[i].x * wv.x + v[i].y * wv.y) + (v[i].z * wv.z + v[i].w * wv.w); }
                a = wave_sum(a);
                if (lane == 0) gates[(size_t)row * 8 + j] = a + gate_b[j];
            }
        }
    }
}

__device__ __forceinline__ void phase_prep(const Params& p, int l) {
    const int gtid = opq_bid() * NTHR + opq_tid(), gn = opq_gdim() * NTHR;
    u16* proj = (u16*)(p.ws + OFF_HP); u16* mqk = (u16*)(p.ws + OFF_MQK);
    const float* retc = (const float*)(p.ws + OFF_TAB); const float* rets = retc + 4096 * 64; const float* difc = rets + 4096 * 64; const float* difs = difc + 4096 * 16;
    const float KS = 0.08838834764831845f;
    for (int i = gtid; i < T_ * 512; i += gn) {
        const int t = i >> 9, r = i & 511, qk = r >> 8, h = (r >> 6) & 3, j = r & 63, s = t & 4095;
        u16* pp = proj + (size_t)t * NPJ + qk * 512 + h * 128 + j;
        const float c = retc[s * 64 + j], sn = rets[s * 64 + j], t1 = bf2f(pp[0]), t2 = bf2f(pp[64]);
        float o1 = t1 * c - t2 * sn, o2 = t1 * sn + t2 * c;
        if (qk) { o1 *= KS; o2 *= KS; }
        pp[0] = f2bf(o1); pp[64] = f2bf(o2);
    }
    for (int i = gtid; i < T_ * 256; i += gn) {
        const int t = i >> 8, r = i & 255, grp = r >> 4, j = r & 15, s = t & 4095;
        u16* pp = proj + (size_t)t * NPJ + 2048 + grp * 128 + j;
        const float c = difc[s * 16 + j], sn = difs[s * 16 + j], t1 = bf2f(pp[0]), t2 = bf2f(pp[16]);
        pp[0] = f2bf(t1 * c - t2 * sn); pp[16] = f2bf(t1 * sn + t2 * c);
    }
    const float* cw = p.in[9] + (size_t)l * 4 * 1024; const float* cb = p.in[10] + (size_t)l * 1024;
    for (int i = gtid; i < T_ * 1024; i += gn) {
        const int t = i >> 10, cc = i & 1023, s = t & 4095;
        float y = cb[cc];
#pragma unroll
        for (int j = 0; j < 4; ++j) { const int sj = s - 3 + j; if (sj >= 0) y += cw[j * 1024 + cc] * bf2f(proj[(size_t)(t - 3 + j) * NPJ + 5120 + cc]); }
        y = silu_f(y); if (cc >= 512) y *= KS;
        mqk[(size_t)t * 1024 + cc] = f2bf(y);
    }
}

__device__ __forceinline__ da::BlockRef<__hip_bfloat16, float> diff_ref(int inst, int qb, const __hip_bfloat16* proj, float* Od) {
    const int b = inst >> 4, h = (inst >> 2) & 3, m = (inst >> 1) & 1, e = inst & 1;
    da::BlockRef<__hip_bfloat16, float> r;
    r.Q = proj + (size_t)(b * 4096 + qb * 256) * NPJ + 2048 + h * 256 + m * 128;
    r.K = proj + (size_t)(b * 4096) * NPJ + 3072 + h * 256 + m * 128;
    r.V = proj + (size_t)(b * 4096) * NPJ + 4096 + h * 256 + e * 128;
    r.O = Od + (size_t)(b * 4096 + qb * 256) * DM + h * 512 + m * 256 + e * 128;
    r.P0 = qb * 256;
    return r;
}
__device__ __forceinline__ void phase_diffattn(const Params& p, unsigned char* lds) {
    typedef __hip_bfloat16 TI;
    const TI* proj = (const TI*)(p.ws + OFF_HP); float* Od = (float*)(p.ws + OFF_Z);
    const int total = 512, stride = opq_gdim();
    const int Wrt = 4096 + (p.ws == nullptr ? 64 : 0), SKVrt = 4096 + (p.out == nullptr ? 64 : 0);
    int L = opq_bid(); if (L >= total) return;
    int pass = 0;
    da::BlockRef<TI, float> cur = diff_ref(L >> 3, L & 7, proj, Od);
    da::Seam<TI> S;
    da::causal_swa_prime<TI, float>(cur, Wrt, (char*)lds, S);
    for (;;) {
        const bool more_pass = pass == 0, more_item = L + stride < total, last = !more_pass && !more_item;
        int passn = pass + 1, Ln = L;
        if (!more_pass) { passn = 0; Ln = more_item ? L + stride : L; }
        const int qbn = passn ? 15 - (Ln & 7) : (Ln & 7);
        const da::BlockRef<TI, float> nxt = last ? cur : diff_ref(Ln >> 3, qbn, proj, Od);
        da::causal_swa_block<TI, float>(cur, nxt, SKVrt, Wrt, (char*)lds, S);
        if (last) break;
        cur = nxt; pass = passn; L = Ln;
    }
}
__device__ __forceinline__ void phase_diffcomb(const Params& p, int l) {
    const int tid = opq_tid(), wid = tid >> 6, lane = tid & 63;
    const float* Od = (const float*)(p.ws + OFF_Z); u16* mixed = (u16*)(p.ws + OFF_XB);
    const float* dl = p.in[7] + (size_t)l * 512; const float* g = p.in[8] + (size_t)l * 256;
    const float lam_init = 0.8f - 0.6f * expf(-0.3f * (float)l);
    const float s1 = wave_sum(dl[lane] * dl[128 + lane] + dl[64 + lane] * dl[192 + lane]);
    const float s2 = wave_sum(dl[256 + lane] * dl[384 + lane] + dl[320 + lane] * dl[448 + lane]);
    const float lam = expf(s1) - expf(s2) + lam_init;
    const float4 gv = ((const float4*)g)[lane];
    const float post = 1.0f - lam_init;
    for (int u = opq_bid() * 8 + wid; u < T_ * 4; u += opq_gdim() * 8) {
        const int t = u >> 2, h = u & 3;
        const float4* o0 = (const float4*)(Od + (size_t)t * DM + h * 512);
        const float4 a0 = o0[lane], a1 = o0[64 + lane];
        float4 v; v.x = a0.x - lam * a1.x; v.y = a0.y - lam * a1.y; v.z = a0.z - lam * a1.z; v.w = a0.w - lam * a1.w;
        const float ss = wave_sum((v.x * v.x + v.y * v.y) + (v.z * v.z + v.w * v.w));
        const float rms = 1.0f / sqrtf(ss * (1.0f / 256.0f) + 1e-6f) * post;
        uint2 w; w.x = pk2(v.x * rms * gv.x, v.y * rms * gv.y); w.y = pk2(v.z * rms * gv.z, v.w * rms * gv.w);
        *(uint2*)(mixed + (size_t)t * DM + 512 + h * 256 + 4 * lane) = w;
    }
}

__device__ __forceinline__ bf16x8_t frag(const u16* base, int rs, int ks, int lane) {
    const u16* q = base + (lane & 15) * rs + (lane >> 4) * 8 * ks;
    bf16x8_t r;
#pragma unroll
    for (int e = 0; e < 8; ++e) r[e] = (short)q[e * ks];
    return r;
}
__device__ __forceinline__ void stage_tile(u16* dst, const u16* src, size_t ld, int L, const float* rowscale) {
    for (int i = opq_tid(); i < L * 16; i += NTHR) {
        const int r = i >> 4, c8 = (i & 15) * 8;
        uint4 v = *(const uint4*)(src + (size_t)r * ld + c8);
        if (rowscale) {
            const float sc = rowscale[r];
            v.x = pk2(bf2f((u16)(v.x & 0xffff)) * sc, bf2f((u16)(v.x >> 16)) * sc); v.y = pk2(bf2f((u16)(v.y & 0xffff)) * sc, bf2f((u16)(v.y >> 16)) * sc);
            v.z = pk2(bf2f((u16)(v.z & 0xffff)) * sc, bf2f((u16)(v.z >> 16)) * sc); v.w = pk2(bf2f((u16)(v.w & 0xffff)) * sc, bf2f((u16)(v.w >> 16)) * sc);
        }
        unsigned* d = (unsigned*)(dst + r * LDT + c8);
        d[0] = v.x; d[1] = v.y; d[2] = v.z; d[3] = v.w;
    }
}
template <int TYPE>
__device__ __forceinline__ void chunk_l1(const Params& p, unsigned char* lds) {
    constexpr int L = TYPE ? 64 : 128, NC = 4096 / L, NIT = 16 * NC;
    const int tid = opq_tid(), wid = tid >> 6, lane = tid & 63;
    u16* sK = (u16*)lds; u16* sV = sK + 128 * LDT; float* sW = (float*)(lds + 2 * 128 * LDT * 2);
    const u16* proj = (const u16*)(p.ws + OFF_HP); const u16* mqk = (const u16*)(p.ws + OFF_MQK); const float* gates = (const float*)(p.ws + OFF_GATE);
    float* ST = (float*)(p.ws + (TYPE ? OFF_STM : OFF_STR)); float* nm = (float*)(p.ws + OFF_NM); float* scb = (float*)(p.ws + OFF_SC);
    for (int it = opq_bid(); it < NIT; it += opq_gdim()) {
        const int bh = it / NC, c = it % NC, b = bh >> 2, h = bh & 3; const size_t t0 = (size_t)b * 4096 + (size_t)c * L;
        __syncthreads();
        if (TYPE == 0) { if (tid < 128) { const float lg = logf(1.0f - exp2f(-5.0f - (float)h)); sW[tid] = expf((float)(127 - tid) * lg); } }
        else if (wid == 0) {
            const float fp = gates[(t0 + lane) * 8 + 4 + h], ip = gates[(t0 + lane) * 8 + h];
            const float bb = scan_sum(logsig_f(fp), lane), bL = __shfl(bb, 63), wl = bL - bb + ip, wmax = wave_max(wl);
            sW[lane] = expf(wl - wmax);
            if (lane == 0) { scb[(bh * 64 + c) * 4 + 0] = bL; scb[(bh * 64 + c) * 4 + 1] = wmax; }
        }
        __syncthreads();
        if (TYPE == 0) { stage_tile(sK, proj + t0 * NPJ + 512 + h * 128, NPJ, L, sW); stage_tile(sV, proj + t0 * NPJ + 1024 + h * 128, NPJ, L, nullptr); }
        else           { stage_tile(sK, mqk + t0 * 1024 + 512 + h * 128, 1024, L, sW); stage_tile(sV, proj + t0 * NPJ + 6144 + h * 128, NPJ, L, nullptr); }
        __syncthreads();
        f32x4_t acc[8];
#pragma unroll
        for (int ct = 0; ct < 8; ++ct) acc[ct] = (f32x4_t){0.f, 0.f, 0.f, 0.f};
        for (int j0 = 0; j0 < L; j0 += 32) {
            const bf16x8_t a = frag(sK + j0 * LDT + 16 * wid, 1, LDT, lane);
#pragma unroll
            for (int ct = 0; ct < 8; ++ct) { const bf16x8_t bb = frag(sV + j0 * LDT + 16 * ct, 1, LDT, lane); acc[ct] = __builtin_amdgcn_mfma_f32_16x16x32_bf16(a, bb, acc[ct], 0, 0, 0); }
        }
        float* dst = ST + (size_t)(bh * NC + c) * 16384;
#pragma unroll
        for (int ct = 0; ct < 8; ++ct)
#pragma unroll
            for (int r = 0; r < 4; ++r) dst[(16 * wid + 4 * (lane >> 4) + r) * 128 + 16 * ct + (lane & 15)] = acc[ct][r];
        if (TYPE == 1 && tid < 128) { float s = 0.f; for (int j = 0; j < L; ++j) s += bf2f(sK[j * LDT + tid]); nm[(size_t)(bh * 64 + c) * 128 + tid] = s; }
    }
}
__device__ __forceinline__ void chunk_scan(const Params& p) {
    const int gtid = opq_bid() * NTHR + opq_tid(), gn = opq_gdim() * NTHR;
    float* str = (float*)(p.ws + OFF_STR); float* stm = (float*)(p.ws + OFF_STM); float* nm = (float*)(p.ws + OFF_NM); float* scb = (float*)(p.ws + OFF_SC);
    for (int u = gtid; u < 16 * 16384; u += gn) {
        const int bh = u >> 14, e = u & 16383, h = bh & 3;
        const float lg = logf(1.0f - exp2f(-5.0f - (float)h)), dec = expf(128.0f * lg);
        float* ptr = str + (size_t)bh * 32 * 16384 + e; float C = 0.f;
#pragma unroll 8
        for (int c = 0; c < 32; ++c) { const float kv = ptr[(size_t)c * 16384]; ptr[(size_t)c * 16384] = C; C = dec * C + kv; }
    }
    for (int u = gtid; u < 16 * 16384; u += gn) {
        const int bh = u >> 14, e = u & 16383;
        float* ptr = stm + (size_t)bh * 64 * 16384 + e; const float* sp = scb + bh * 64 * 4; float C = 0.f, m = 0.f;
#pragma unroll 8
        for (int c = 0; c < 64; ++c) {
            const float bL = sp[c * 4], wmax = sp[c * 4 + 1], mn = fmaxf(bL + m, wmax), dec = expf(bL + m - mn), sc = expf(wmax - mn);
            const float kv = ptr[(size_t)c * 16384]; ptr[(size_t)c * 16384] = C; C = dec * C + sc * kv; m = mn; }
    }
    for (int u = gtid; u < 16 * 128; u += gn) {
        const int bh = u >> 7, e = u & 127;
        float* ptr = nm + (size_t)bh * 64 * 128 + e; float* sp = scb + bh * 64 * 4; float C = 0.f, m = 0.f;
        for (int c = 0; c < 64; ++c) {
            const float bL = sp[c * 4], wmax = sp[c * 4 + 1], mn = fmaxf(bL + m, wmax), dec = expf(bL + m - mn), sc = expf(wmax - mn);
            const float kv = ptr[c * 128]; ptr[c * 128] = C; if (e == 0) sp[c * 4 + 2] = m; C = dec * C + sc * kv; m = mn; }
    }
}
template <int TYPE>
__device__ __forceinline__ void chunk_l3(const Params& p, int l, unsigned char* lds) {
    constexpr int L = TYPE ? 64 : 128, NC = 4096 / L, NIT = 16 * NC, NRT = L / 16, WPR = 8 / NRT, NCT = 8 / WPR;
    const int tid = opq_tid(), wid = tid >> 6, lane = tid & 63;
    u16* sQ = (u16*)lds; u16* sK = sQ + 128 * LDT; u16* sV = sK + 128 * LDT; u16* sC = sV + 128 * LDT;
    float* sF = (float*)(lds + 4 * 128 * LDT * 2);
    float* rowoff = sF, * uvec = sF + 128, * inter = sF + 256, * emt = sF + 384, * den = sF + 512, * qn = sF + 640, * nst = sF + 768;
    float* sH = (float*)lds;
    const u16* proj = (const u16*)(p.ws + OFF_HP); const u16* mqk = (const u16*)(p.ws + OFF_MQK); const float* gates = (const float*)(p.ws + OFF_GATE);
    const float* ST = (const float*)(p.ws + (TYPE ? OFF_STM : OFF_STR)); const float* nm = (const float*)(p.ws + OFF_NM); const float* scb = (const float*)(p.ws + OFF_SC);
    u16* mixed = (u16*)(p.ws + OFF_XB);
    const float* ng = TYPE ? (p.in[12] + (size_t)l * 512) : (p.in[6] + (size_t)l * 512);
    for (int it = opq_bid(); it < NIT; it += opq_gdim()) {
        const int bh = it / NC, c = it % NC, b = bh >> 2, h = bh & 3; const size_t t0 = (size_t)b * 4096 + (size_t)c * L;
        __syncthreads();
        if (TYPE == 0) { stage_tile(sQ, proj + t0 * NPJ + h * 128, NPJ, L, nullptr); stage_tile(sK, proj + t0 * NPJ + 512 + h * 128, NPJ, L, nullptr); stage_tile(sV, proj + t0 * NPJ + 1024 + h * 128, NPJ, L, nullptr); }
        else           { stage_tile(sQ, mqk + t0 * 1024 + h * 128, 1024, L, nullptr); stage_tile(sK, mqk + t0 * 1024 + 512 + h * 128, 1024, L, nullptr); stage_tile(sV, proj + t0 * NPJ + 6144 + h * 128, NPJ, L, nullptr); }
        {
            const float4* Cg = (const float4*)(ST + (size_t)(bh * NC + c) * 16384);
            for (int i = tid; i < 4096; i += NTHR) { const float4 v = Cg[i]; const int d = i >> 5, v0 = (i & 31) * 4; unsigned* dd = (unsigned*)(sC + d * LDT + v0); dd[0] = pk2(v.x, v.y); dd[1] = pk2(v.z, v.w); }
        }
        if (TYPE == 0) {
            if (tid < 128) { const float lg = logf(1.0f - exp2f(-5.0f - (float)h)), bi = (float)(tid + 1) * lg; rowoff[tid] = bi; uvec[tid] = -bi; inter[tid] = expf(bi); emt[tid] = 1.0f; }
        } else {
            if (wid == 0) {
                const float fp = gates[(t0 + lane) * 8 + 4 + h], ip = gates[(t0 + lane) * 8 + h];
                const float bb = scan_sum(logsig_f(fp), lane), uu = ip - bb, pm = scan_max(uu, lane), m_in = scb[(bh * 64 + c) * 4 + 2];
                const float mt = bb + fmaxf(m_in, pm);
                rowoff[lane] = bb - mt; uvec[lane] = uu; inter[lane] = expf(bb + m_in - mt); emt[lane] = expf(-mt);
            }
            if (tid >= 128 && tid < 256) nst[tid - 128] = nm[(size_t)(bh * 64 + c) * 128 + tid - 128];
        }
        __syncthreads();
        f32x4_t sacc[NRT];
        if (wid < NRT) {
#pragma unroll
            for (int ct = 0; ct < NRT; ++ct) sacc[ct] = (f32x4_t){0.f, 0.f, 0.f, 0.f};
            for (int d0 = 0; d0 < 128; d0 += 32) {
                const bf16x8_t a = frag(sQ + 16 * wid * LDT + d0, LDT, 1, lane);
#pragma unroll
                for (int ct = 0; ct < NRT; ++ct) { const bf16x8_t bb = frag(sK + 16 * ct * LDT + d0, LDT, 1, lane); sacc[ct] = __builtin_amdgcn_mfma_f32_16x16x32_bf16(a, bb, sacc[ct], 0, 0, 0); }
            }
        }
        if (TYPE == 1) {
            for (int i = wid; i < L; i += 8) { float s = bf2f(sQ[i * LDT + lane]) * nst[lane] + bf2f(sQ[i * LDT + 64 + lane]) * nst[64 + lane]; s = wave_sum(s); if (lane == 0) qn[i] = s; }
        }
        __syncthreads();
        u16* sP = sK;
        if (wid < NRT) {
#pragma unroll
            for (int r = 0; r < 4; ++r) {
                const int i = 16 * wid + 4 * (lane >> 4) + r; const float ro = rowoff[i]; float rs = 0.f;
#pragma unroll
                for (int ct = 0; ct < NRT; ++ct) { const int j = 16 * ct + (lane & 15); const float pv = (j <= i) ? sacc[ct][r] * expf(ro + uvec[j]) : 0.f; rs += pv; sP[i * LDT + j] = f2bf(pv); }
                rs += __shfl_xor(rs, 1); rs += __shfl_xor(rs, 2); rs += __shfl_xor(rs, 4); rs += __shfl_xor(rs, 8);
                if ((lane & 15) == 0) den[i] = rs;
            }
        }
        __syncthreads();
        const int rt = wid % NRT, ctb = (wid / NRT) * NCT;
        f32x4_t acc[NCT];
#pragma unroll
        for (int ct = 0; ct < NCT; ++ct) acc[ct] = (f32x4_t){0.f, 0.f, 0.f, 0.f};
        for (int d0 = 0; d0 < 128; d0 += 32) {
            const bf16x8_t a = frag(sQ + 16 * rt * LDT + d0, LDT, 1, lane);
#pragma unroll
            for (int ct = 0; ct < NCT; ++ct) { const bf16x8_t bb = frag(sC + d0 * LDT + 16 * (ctb + ct), 1, LDT, lane); acc[ct] = __builtin_amdgcn_mfma_f32_16x16x32_bf16(a, bb, acc[ct], 0, 0, 0); }
        }
#pragma unroll
        for (int r = 0; r < 4; ++r) { const float sc = inter[16 * rt + 4 * (lane >> 4) + r];
#pragma unroll
            for (int ct = 0; ct < NCT; ++ct) acc[ct][r] *= sc; }
        for (int j0 = 0; j0 < L; j0 += 32) {
            const bf16x8_t a = frag(sP + 16 * rt * LDT + j0, LDT, 1, lane);
#pragma unroll
            for (int ct = 0; ct < NCT; ++ct) { const bf16x8_t bb = frag(sV + j0 * LDT + 16 * (ctb + ct), 1, LDT, lane); acc[ct] = __builtin_amdgcn_mfma_f32_16x16x32_bf16(a, bb, acc[ct], 0, 0, 0); }
        }
        __syncthreads();
#pragma unroll
        for (int ct = 0; ct < NCT; ++ct)
#pragma unroll
            for (int r = 0; r < 4; ++r) sH[(16 * rt + 4 * (lane >> 4) + r) * 129 + 16 * (ctb + ct) + (lane & 15)] = acc[ct][r];
        __syncthreads();
        const float g0 = ng[h * 128 + 2 * lane], g1 = ng[h * 128 + 2 * lane + 1];
        for (int i = wid; i < L; i += 8) {
            const size_t t = t0 + i;
            float h0 = sH[i * 129 + 2 * lane], h1 = sH[i * 129 + 2 * lane + 1];
            if (TYPE == 1) {
                const float dn = den[i] + inter[i] * qn[i], dd = fmaxf(fabsf(dn), emt[i]);
                const unsigned og = *(const unsigned*)(proj + t * NPJ + 6656 + h * 128 + 2 * lane);
                h0 = h0 / dd * sigmoid_f(bf2f((u16)(og & 0xffff))); h1 = h1 / dd * sigmoid_f(bf2f((u16)(og >> 16)));
            }
            const float mean = wave_sum(h0 + h1) * (1.0f / 128.0f), d0 = h0 - mean, d1 = h1 - mean;
            const float var = wave_sum(d0 * d0 + d1 * d1) * (1.0f / 128.0f), rstd = 1.0f / sqrtf(var + 1e-6f);
            float y0 = d0 * rstd * g0, y1 = d1 * rstd * g1;
            int col;
            if (TYPE == 0) {
                const unsigned rg = *(const unsigned*)(proj + t * NPJ + 1536 + h * 128 + 2 * lane);
                y0 *= silu_f(bf2f((u16)(rg & 0xffff))); y1 *= silu_f(bf2f((u16)(rg >> 16))); col = h * 128 + 2 * lane;
            } else col = 1536 + h * 128 + 2 * lane;
            *(unsigned*)(mixed + t * DM + col) = pk2(y0, y1);
        }
    }
}

__device__ __forceinline__ Params load_params() {
    Params r{};
#if defined(__HIP_DEVICE_COMPILE__)
    const __attribute__((address_space(4))) Params* k = (const __attribute__((address_space(4))) Params*)__builtin_amdgcn_kernarg_segment_ptr();
    asm volatile("" : "+s"(k));
#pragma unroll
    for (int i = 0; i < 16; ++i) r.in[i] = k->in[i];
    r.out = k->out; r.ws = k->ws;
#endif
    return r;
}
#define PWS(off) (q.ws + (off))
#ifndef PHMASK
#define PHMASK 0xFFFF
#endif
__global__ void __launch_bounds__(NTHR, 2) fwd_megakernel(Params p_unused) {
    extern __shared__ __attribute__((aligned(16))) unsigned char lds[];
    cg::grid_group grid = cg::this_grid();
    const float ALPHA = 1.41421356237309515f;
    { const Params q = load_params(); phase_init(q); }
#pragma unroll 1
    for (int l = 0; l < 2; ++l) {
        { const Params q = load_params(); phase_weights(q, l, lds); }
        grid.sync();
        { const Params q = load_params(); EpiSwiGLU e; e.H = (u16*)PWS(OFF_HP); run_gemm(lds, (const u16*)PWS(OFF_XB), (const u16*)PWS(OFF_WGU1), T_, NGU, DM, e); }
        grid.sync();
        { const Params q = load_params(); EpiResid e; e.X = q.out; e.Z = (float*)PWS(OFF_Z); e.alpha = ALPHA; e.s = 0.5f; run_gemm(lds, (const u16*)PWS(OFF_HP), (const u16*)PWS(OFF_WD1), T_, DM, DFF, e); }
        grid.sync();
        { const Params q = load_params(); phase_ln<true>((const float*)PWS(OFF_Z), q.in[1] + (size_t)(l * 3 + 0) * DM, q.in[2] + (size_t)(l * 3 + 0) * DM, q.out, (u16*)PWS(OFF_XB), q.in[5] + (size_t)l * DM * PW, q.in[11] + (size_t)l * 8, (float*)PWS(OFF_GATE), (float*)lds); }
        grid.sync();
        { const Params q = load_params(); pg8::EpiBf16<0> e; e.O = (u16*)PWS(OFF_HP); e.ldc = NPJ; e.bias = nullptr; e.split_cols = 0; e.split_stride = 0; run_gemm(lds, (const u16*)PWS(OFF_XB), (const u16*)PWS(OFF_WIN), T_, NPJ, DM, e); }
        grid.sync();
        { const Params q = load_params(); phase_prep(q, l); }
        grid.sync();
#if PHMASK & 128
        { const Params q = load_params(); phase_diffattn(q, lds); }
#endif
        { const Params q = load_params(); chunk_l1<0>(q, lds); }
        { const Params q = load_params(); chunk_l1<1>(q, lds); }
        grid.sync();
        { const Params q = load_params(); chunk_scan(q); }
        grid.sync();
        { const Params q = load_params(); chunk_l3<0>(q, l, lds); }
        { const Params q = load_params(); chunk_l3<1>(q, l, lds); }
        { const Params q = load_params(); phase_diffcomb(q, l); }
        grid.sync();
        { const Params q = load_params(); EpiResid e; e.X = q.out; e.Z = (float*)PWS(OFF_Z); e.alpha = ALPHA; e.s = 1.0f; run_gemm(lds, (const u16*)PWS(OFF_XB), (const u16*)PWS(OFF_WOUT), T_, DM, DM, e); }
        grid.sync();
        { const Params q = load_params(); phase_ln<false>((const float*)PWS(OFF_Z), q.in[1] + (size_t)(l * 3 + 1) * DM, q.in[2] + (size_t)(l * 3 + 1) * DM, q.out, (u16*)PWS(OFF_XB), nullptr, nullptr, nullptr, (float*)lds); }
        grid.sync();
        { const Params q = load_params(); EpiSwiGLU e; e.H = (u16*)PWS(OFF_HP); run_gemm(lds, (const u16*)PWS(OFF_XB), (const u16*)PWS(OFF_WGU2), T_, NGU, DM, e); }
        grid.sync();
        { const Params q = load_params(); EpiResid e; e.X = q.out; e.Z = (float*)PWS(OFF_Z); e.alpha = ALPHA; e.s = 0.5f; run_gemm(lds, (const u16*)PWS(OFF_HP), (const u16*)PWS(OFF_WD2), T_, DM, DFF, e); }
        grid.sync();
        { const Params q = load_params(); phase_ln<false>((const float*)PWS(OFF_Z), q.in[1] + (size_t)(l * 3 + 2) * DM, q.in[2] + (size_t)(l * 3 + 2) * DM, q.out, (u16*)PWS(OFF_XB), nullptr, nullptr, nullptr, (float*)lds); }
        grid.sync();
    }
}

extern "C" void kernel_launch(void* const* d_in, const int* in_sizes, int n_in, void* d_out, int out_size, void* d_ws, size_t ws_size, hipStream_t stream) {
    static int grid_blocks = 0;
    if (grid_blocks == 0) {
        if (n_in != 16 || out_size != T_ * DM || ws_size < WS_END) { fprintf(stderr, "kernel_launch: unexpected shapes (n_in %d out %d ws %zu need %zu)\n", n_in, out_size, ws_size, (size_t)WS_END); grid_blocks = -1; return; }
        int dev = 0, cus = 0, per_cu = 0;
        (void)hipGetDevice(&dev);
        (void)hipDeviceGetAttribute(&cus, hipDeviceAttributeMultiprocessorCount, dev);
        if (hipFuncSetAttribute((const void*)fwd_megakernel, hipFuncAttributeMaxDynamicSharedMemorySize, LDS_TOTAL) != hipSuccess) fprintf(stderr, "kernel_launch: hipFuncSetAttribute failed\n");
        if (hipOccupancyMaxActiveBlocksPerMultiprocessor(&per_cu, (const void*)fwd_megakernel, NTHR, LDS_TOTAL) != hipSuccess || per_cu < 1) { fprintf(stderr, "kernel_launch: occupancy query gave %d\n", per_cu); per_cu = 1; }
        (void)hipGetLastError();
        if (cus <= 0) cus = 256;
        grid_blocks = cus * per_cu;
    }
    if (grid_blocks < 0) return;
    Params p{};
    for (int i = 0; i < 16; ++i) p.in[i] = (const float*)d_in[i];
    p.out = (float*)d_out; p.ws = (unsigned char*)d_ws;
    void* args[] = {&p};
    hipError_t e = hipLaunchCooperativeKernel((const void*)fwd_megakernel, dim3(grid_blocks), dim3(NTHR), args, LDS_TOTAL, stream);
    if (e != hipSuccess) fprintf(stderr, "kernel_launch: cooperative launch failed: %s (grid %d)\n", hipGetErrorString(e), grid_blocks);
}
```

```cpp
#include <hip/hip_runtime.h>
#include <hip/hip_bf16.h>
#include <hip/hip_cooperative_groups.h>
#include <cstdio>
#include <cstdint>
namespace cg = cooperative_groups;
__device__ __forceinline__ int opq_tid() { int t = (int)threadIdx.x; asm volatile("" : "+v"(t)); return t; }
__device__ __forceinline__ int opq_bid() { int t = (int)blockIdx.x; asm volatile("" : "+s"(t)); return t; }
__device__ __forceinline__ int opq_gdim() { int t = (int)gridDim.x; asm volatile("" : "+s"(t)); return t; }
__device__ __forceinline__ float opq_f(float x) { asm volatile("" : "+v"(x)); return x; }

#define XB_TMO      128
#define XB_XCNT(j)  (256  + 64 * (j))
#define XB_XSUB(j)  (1280 + 64 * (j))
#define XB_XGEN(j)  (2304 + 64 * (j))
#define XB_TOP      3328
#define XB_TOPGEN   3392
#define XCD_BAR_WORDS 3456
#define XB_SPIN_CAP (1u << 18)
#define LAS __attribute__((address_space(3)))

__device__ __forceinline__ unsigned xb_ld(unsigned* p)              { return __hip_atomic_load(p, __ATOMIC_RELAXED, __HIP_MEMORY_SCOPE_AGENT); }
__device__ __forceinline__ unsigned xb_add(unsigned* p, unsigned v) { return __hip_atomic_fetch_add(p, v, __ATOMIC_RELAXED, __HIP_MEMORY_SCOPE_AGENT); }
__device__ __forceinline__ unsigned xb_xcc_id() { return (unsigned)__builtin_amdgcn_s_getreg((3 << 11) | 20) & 0xFu; }
#define XB_SPIN(cond, bar) do { unsigned _sp = 0; while (cond) { __builtin_amdgcn_s_sleep(1); \
    if ((++_sp & 255u) == 0u) { if (xb_ld(&(bar)[XB_TMO])) break; if (_sp > XB_SPIN_CAP) { atomicAdd(&(bar)[XB_TMO], 1u); break; } } } } while (0)

struct XcdBarrier {
    unsigned* bar; unsigned x;
    volatile LAS unsigned* st;
};

__device__ __forceinline__ XcdBarrier xcd_barrier_post(unsigned* bar, volatile LAS unsigned* st) {
    XcdBarrier b; b.bar = bar; b.x = xb_xcc_id(); b.st = st;
    if (opq_tid() == 0) (void)xb_add(&bar[XB_XCNT(b.x)], 1u);
    return b;
}
__device__ __forceinline__ void xcd_barrier_complete(unsigned* bar, unsigned x, unsigned& nloc, unsigned& nx) {
    const unsigned G = (unsigned)opq_gdim();
    unsigned sum, cnt, mine, sp = 0u;
    for (;;) {
        sum = 0u; cnt = 0u; mine = 0u;
#pragma unroll
        for (unsigned j = 0; j < 16; ++j) { const unsigned c = xb_ld(&bar[XB_XCNT(j)]); sum += c; cnt += (c > 0u) ? 1u : 0u; mine = (j == x) ? c : mine; }
        if (sum == G) break;
        __builtin_amdgcn_s_sleep(1);
        if ((++sp & 255u) == 0u) { if (xb_ld(&bar[XB_TMO])) break; if (sp > XB_SPIN_CAP) { atomicAdd(&bar[XB_TMO], 1u); break; } }
    }
    nloc = mine > 0u ? mine : 1u; nx = cnt > 0u ? cnt : 1u;
}

__device__ __forceinline__ void xcd_barrier(const XcdBarrier& b) {
    asm volatile("s_waitcnt vmcnt(0)" ::: "memory");
    __syncthreads();
    if (opq_tid() == 0) {
        unsigned* bar = b.bar;
        __builtin_amdgcn_s_waitcnt(0);
        unsigned nloc = b.st[0], nx = b.st[1];
        if (nloc == 0u) { xcd_barrier_complete(bar, b.x, nloc, nx); b.st[0] = nloc; b.st[1] = nx; }
        const unsigned old = xb_add(&bar[XB_XSUB(b.x)], 1u);
        const unsigned gen = old / nloc;
        if (old + 1u == (gen + 1u) * nloc) {
            __builtin_amdgcn_fence(__ATOMIC_RELEASE, "agent");
            asm volatile("s_waitcnt vmcnt(0)" ::: "memory");
            const unsigned og = xb_add(&bar[XB_TOP], 1u);
            const unsigned tg = og / nx;
            if (og + 1u == (tg + 1u) * nx) xb_add(&bar[XB_TOPGEN], 1u);
            else XB_SPIN(xb_ld(&bar[XB_TOPGEN]) == tg, bar);
            __builtin_amdgcn_fence(__ATOMIC_ACQUIRE, "agent");
            xb_add(&bar[XB_XGEN(b.x)], 1u);
            asm volatile("s_waitcnt vmcnt(0)" ::: "memory");
        } else {
            XB_SPIN(xb_ld(&bar[XB_XGEN(b.x)]) == gen, bar);
            __builtin_amdgcn_fence(__ATOMIC_ACQUIRE, "agent");
            asm volatile("s_waitcnt vmcnt(0)" ::: "memory");
        }
    }
    __syncthreads();
}

namespace pg8 {
#define PG8_LAS __attribute__((address_space(3)))
typedef unsigned short bf16_t;
typedef short bf16x8 __attribute__((ext_vector_type(8)));
typedef float f32x4 __attribute__((ext_vector_type(4)));
typedef unsigned u32x4 __attribute__((ext_vector_type(4)));
constexpr int BM = 256, BK = 64, HALF = 128, HTB = HALF * BK * 2  , STAGE_BYTES = 8 * HTB, NXCD = 8, WGM = 8;

__host__ __device__ __forceinline__ int lds_byte(int r, int c) { const int st = (r >> 4) * 2 + (c >> 5), rr = r & 15, cc = c & 31, ob = rr * 64 + cc * 2; return st * 1024 + (ob ^ (((ob >> 9) & 1) << 5)); }
__host__ __device__ __forceinline__ void stage_rc(int b, int& R, int& C) { const int st = b / 1024, sb = b % 1024, swz = sb ^ (((sb >> 9) & 1) << 5); R = (st >> 1) * 16 + swz / 64; C = (st & 1) * 32 + (swz % 64) / 2; }
__host__ __device__ __forceinline__ int perm32(int rho) { const int n = rho >> 4, i = rho & 15; return 8 * (i >> 2) + 4 * n + (i & 3); }

struct Unit { int pm, pn; };
struct Gemm { const bf16_t* A; const bf16_t* Bt; int M, N, K; };

struct StaticOrder {
    int nM, nN, nwg, G, c;
    __host__ __device__ void init(int M, int N, int G_, int c_) { nM = M / BM; nN = N / BM; nwg = nM * nN; G = G_; c = c_; }
    __host__ __device__ bool next(int i, Unit& u) const {
        const long L = (long)i * G + c; if (L >= nwg) return false;
        int wgid = (int)L; { const int q = nwg / NXCD, r = nwg % NXCD, xcd = wgid % NXCD, off = wgid / NXCD; wgid = (xcd < r ? xcd * (q + 1) : r * (q + 1) + (xcd - r) * q) + off; }
        const int nig = WGM * nN, gid = wgid / nig, fm = gid * WGM, gsz = (nM - fm) < WGM ? (nM - fm) : WGM;
        u.pm = fm + ((wgid % nig) % gsz); u.pn = (wgid % nig) / gsz; return true;
    }
    __device__ __forceinline__ void a_ready(const Unit&) const {}
    __device__ __forceinline__ void done(const Unit&) const {}
};
__device__ __forceinline__ unsigned cvt_pk_bf16(float lo, float hi) { unsigned r; asm volatile("v_cvt_pk_bf16_f32 %0, %1, %2" : "=v"(r) : "v"(lo), "v"(hi)); return r; }
typedef float f32x2 __attribute__((ext_vector_type(2)));
__device__ __forceinline__ f32x2 gelu_pk(f32x2 v) {
    const f32x2 av = __builtin_elementwise_abs(v), d = av * 0.2316418882f + 1.0f;
    f32x2 t; t.x = __builtin_amdgcn_rcpf(d.x); t.y = __builtin_amdgcn_rcpf(d.y);
    f32x2 q = t * 0.5307027145f + (-0.7265760135f); q = q * t + 0.7107068705f; q = q * t + (-0.142248368f); q = q * t + 0.127414796f; q = q * t;
    const f32x2 s = (v * v) * (-0.72134752044f);
    f32x2 e; e.x = __builtin_amdgcn_exp2f(s.x); e.y = __builtin_amdgcn_exp2f(s.y);
    const f32x2 m = v * (q * e), r = v - m;
    f32x2 o; o.x = v.x < 0.f ? m.x : r.x; o.y = v.y < 0.f ? m.y : r.y; return o;
}

struct EpiF32 {
    static constexpr bool PERM = false, AFTER_DRAIN = false;
    float* C; int ldc; const float* bias;
    __device__ __forceinline__ void operator()(const f32x4 (&acc)[2][2][4][2], const Unit& u, int wr, int wc, int fr, int fq) const {
        const int row0 = u.pm * BM + wr * 64 + fr, col0 = u.pn * BM + wc * 32 + 4 * fq;
        f32x4 bv[2][2];
#pragma unroll
        for (int bj = 0; bj < 2; ++bj)
#pragma unroll
            for (int n = 0; n < 2; ++n) bv[bj][n] = bias ? *(const f32x4*)(bias + col0 + bj * HALF + n * 16) : (f32x4){0.f, 0.f, 0.f, 0.f};
#pragma unroll
        for (int ai = 0; ai < 2; ++ai)
#pragma unroll
            for (int m = 0; m < 4; ++m) { float* rowp = C + (size_t)(row0 + ai * HALF + m * 16) * ldc + col0;
#pragma unroll
                for (int bj = 0; bj < 2; ++bj)
#pragma unroll
                    for (int n = 0; n < 2; ++n) *(f32x4*)(rowp + bj * HALF + n * 16) = acc[ai][bj][m][n] + bv[bj][n]; }
    }
};
template <int ACT  > struct EpiBf16 {
    static constexpr bool PERM = true, AFTER_DRAIN = false;
    bf16_t* O; int ldc; const float* bias; int split_cols; size_t split_stride;
    __device__ __forceinline__ void operator()(const f32x4 (&acc)[2][2][4][2], const Unit& u, int wr, int wc, int fr, int fq) const {
        const int row0 = u.pm * BM + wr * 64 + fr; int colt = u.pn * BM; bf16_t* base = O;
        if (split_cols) { const int t = colt / split_cols; base += (size_t)t * split_stride; colt -= t * split_cols; }
        const int col0 = colt + wc * 32 + 8 * fq, bcol0 = u.pn * BM + wc * 32 + 8 * fq;
        f32x4 bv[2][2];
#pragma unroll
        for (int bj = 0; bj < 2; ++bj)
#pragma unroll
            for (int n = 0; n < 2; ++n) bv[bj][n] = bias ? *(const f32x4*)(bias + bcol0 + bj * HALF + 4 * n) : (f32x4){0.f, 0.f, 0.f, 0.f};
#pragma unroll
        for (int ai = 0; ai < 2; ++ai)
#pragma unroll
            for (int m = 0; m < 4; ++m) { bf16_t* rowp = base + (size_t)(row0 + ai * HALF + m * 16) * ldc + col0;
#pragma unroll
                for (int bj = 0; bj < 2; ++bj) { f32x4 v0 = acc[ai][bj][m][0] + bv[bj][0], v1 = acc[ai][bj][m][1] + bv[bj][1];
                    if (ACT == 1) { f32x2 a = gelu_pk((f32x2){v0[0], v0[1]}), b = gelu_pk((f32x2){v0[2], v0[3]}), c = gelu_pk((f32x2){v1[0], v1[1]}), d = gelu_pk((f32x2){v1[2], v1[3]});
                        v0 = (f32x4){a.x, a.y, b.x, b.y}; v1 = (f32x4){c.x, c.y, d.x, d.y}; }
                    if (ACT == 2) {
#pragma unroll
                        for (int j = 0; j < 4; ++j) { v0[j] = 0.5f * v0[j] * (1.0f + erff(v0[j] * 0.70710678f)); v1[j] = 0.5f * v1[j] * (1.0f + erff(v1[j] * 0.70710678f)); } }
                    u32x4 w; w.x = cvt_pk_bf16(v0[0], v0[1]); w.y = cvt_pk_bf16(v0[2], v0[3]); w.z = cvt_pk_bf16(v1[0], v1[1]); w.w = cvt_pk_bf16(v1[2], v1[3]);
                    *(u32x4*)(rowp + bj * HALF) = w; } }
    }
};

template <class Epi, class Sched, bool STAMP = false>
__device__ __forceinline__ void gemm_phase(PG8_LAS unsigned char* lds, const Gemm g, const Sched& S, const Epi& E, unsigned long long* stamps) {
    const int tid = opq_tid(), wid = __builtin_amdgcn_readfirstlane(tid >> 6), lane = tid & 63, wr = wid >> 2, wc = wid & 3, fr = lane & 15, fq = lane >> 4;
    const int K = g.K, nt = K / BK;
    int ts_lo = 0, ts_hi = 0, nts = 0; const unsigned long long rt_entry = STAMP ? (unsigned long long)wall_clock64() : 0ull;
#define PG8_STAMP() do { if (STAMP && wid == 0 && nts < 64) { const unsigned long long _c = (unsigned long long)clock64(); \
        ts_lo = (lane == nts) ? (int)(unsigned)_c : ts_lo; ts_hi = (lane == nts) ? (int)(unsigned)(_c >> 32) : ts_hi; ++nts; } } while (0)
    PG8_STAMP();
    unsigned voffA[2], voffB[2];
#pragma unroll
    for (int i = 0; i < 2; ++i) { int R, C; stage_rc(tid * 16 + i * 8192, R, C); const int Rb = Epi::PERM ? ((R & ~31) + perm32(R & 31)) : R;
        voffA[i] = (unsigned)(R * K + C) * 2u; voffB[i] = (unsigned)(Rb * K + C) * 2u; }
    const size_t kstep = (size_t)(BK * 2);
    const size_t hstep = (size_t)HALF * K * 2;
    const size_t tstep = 2 * hstep;
    const unsigned ldsw = (unsigned)wid * 1024u;
    const int aoff = lds_byte(wr * 64 + fr, fq * 8), boff = lds_byte(wc * 32 + fr, fq * 8);
#define PG8_SA(b, h) (((b) * 2 + (h)) * HTB)
#define PG8_SB(b, h) ((4 + (b) * 2 + (h)) * HTB)
#define PG8_STAGE(bufoff, gbase, voff) do { _Pragma("unroll") for (int _i = 0; _i < 2; ++_i) \
        __builtin_amdgcn_global_load_lds((const unsigned*)((const char*)(gbase) + (voff)[_i]), (PG8_LAS unsigned*)(lds + (bufoff) + ldsw + _i * 8192), 16, 0, 0); } while (0)
#define PG8_LDA(dst, b, h) do { _Pragma("unroll") for (int m = 0; m < 4; ++m) _Pragma("unroll") for (int k = 0; k < 2; ++k) dst[m][k] = *(const PG8_LAS bf16x8*)(lds + PG8_SA(b, h) + aoff + m * 2048 + k * 1024); } while (0)
#define PG8_LDB(dst, b, h) do { _Pragma("unroll") for (int n = 0; n < 2; ++n) _Pragma("unroll") for (int k = 0; k < 2; ++k) dst[n][k] = *(const PG8_LAS bf16x8*)(lds + PG8_SB(b, h) + boff + n * 2048 + k * 1024); } while (0)
#define PG8_MMA(ai, bj, At, Bt) do { __builtin_amdgcn_s_setprio(1); _Pragma("unroll") for (int m = 0; m < 4; ++m) _Pragma("unroll") for (int n = 0; n < 2; ++n) _Pragma("unroll") for (int k = 0; k < 2; ++k) \
        acc[ai][bj][m][n] = __builtin_amdgcn_mfma_f32_16x16x32_bf16(Bt[n][k], At[m][k], acc[ai][bj][m][n], 0, 0, 0); __builtin_amdgcn_s_setprio(0); } while (0)
#define PG8_WAIT_V(n) asm volatile("s_waitcnt vmcnt(" #n ")" ::: "memory")
#define PG8_WAIT_L(n) asm volatile("s_waitcnt lgkmcnt(" #n ")" ::: "memory")
#define PG8_BAR __builtin_amdgcn_s_barrier()
#define PG8_SCHED __builtin_amdgcn_sched_barrier(0)
    Unit cur, nxt; int ui = 0;
    if (!S.next(0, cur)) return;
    f32x4 acc[2][2][4][2];
#pragma unroll
    for (int a = 0; a < 2; ++a)
#pragma unroll
        for (int b = 0; b < 2; ++b)
#pragma unroll
            for (int m = 0; m < 4; ++m)
#pragma unroll
                for (int n = 0; n < 2; ++n) acc[a][b][m][n] = (f32x4){0.f, 0.f, 0.f, 0.f};
    bf16x8 At[4][2], B0[2][2], B1[2][2];
    const char* cA = (const char*)g.A + (size_t)cur.pm * tstep; const char* cB = (const char*)g.Bt + (size_t)cur.pn * tstep;
    S.a_ready(cur);
    PG8_STAGE(PG8_SB(0, 0), cB, voffB); PG8_STAGE(PG8_SA(0, 0), cA, voffA); PG8_STAGE(PG8_SB(0, 1), cB + hstep, voffB); PG8_STAGE(PG8_SA(0, 1), cA + hstep, voffA);
    if (wr == 1) PG8_BAR;
    PG8_WAIT_V(4); PG8_BAR;
    PG8_STAGE(PG8_SB(1, 0), cB + kstep, voffB); PG8_STAGE(PG8_SA(1, 0), cA + kstep, voffA); PG8_STAGE(PG8_SB(1, 1), cB + hstep + kstep, voffB);
    PG8_WAIT_V(6); PG8_BAR;
    PG8_STAMP();
    for (;;) {
        const bool has_next = S.next(ui + 1, nxt);
        const char* nA = has_next ? (const char*)g.A + (size_t)nxt.pm * tstep : cA; const char* nB = has_next ? (const char*)g.Bt + (size_t)nxt.pn * tstep : cB;
        for (int t = 0; t < nt; t += 2) {
            const bool last = (t == nt - 2);
            const char* a1 = cA + (size_t)(t + 1) * kstep;
            const char* a2 = last ? nA : cA + (size_t)(t + 2) * kstep; const char* b2 = last ? nB : cB + (size_t)(t + 2) * kstep;
            const char* a3 = a2 + kstep; const char* b3 = b2 + kstep;
            if (last && has_next) S.a_ready(nxt);
            PG8_LDB(B0, 0, 0); PG8_SCHED; PG8_LDA(At, 0, 0); PG8_STAGE(PG8_SA(1, 1), a1 + hstep, voffA);
            PG8_WAIT_L(8); PG8_BAR; PG8_WAIT_L(0); PG8_MMA(0, 0, At, B0); PG8_BAR; PG8_SCHED;
            PG8_LDB(B1, 0, 1); PG8_STAGE(PG8_SB(0, 0), b2, voffB);
            PG8_BAR; PG8_WAIT_L(0); PG8_MMA(0, 1, At, B1); PG8_BAR;
            PG8_LDA(At, 0, 1); PG8_STAGE(PG8_SA(0, 0), a2, voffA);
            PG8_BAR; PG8_WAIT_L(0); PG8_MMA(1, 0, At, B0); PG8_BAR; PG8_SCHED;
            PG8_STAGE(PG8_SB(0, 1), b2 + hstep, voffB);
            PG8_WAIT_V(6); PG8_BAR; PG8_MMA(1, 1, At, B1); PG8_BAR;
            PG8_LDB(B0, 1, 0); PG8_SCHED; PG8_LDA(At, 1, 0); PG8_STAGE(PG8_SA(0, 1), a2 + hstep, voffA);
            PG8_WAIT_L(8); PG8_BAR; PG8_WAIT_L(0); PG8_MMA(0, 0, At, B0); PG8_BAR; PG8_SCHED;
            PG8_LDB(B1, 1, 1); PG8_STAGE(PG8_SB(1, 0), b3, voffB);
            PG8_BAR; PG8_WAIT_L(0); PG8_MMA(0, 1, At, B1); PG8_BAR;
            PG8_LDA(At, 1, 1); PG8_STAGE(PG8_SA(1, 0), a3, voffA);
            PG8_BAR; PG8_WAIT_L(0); PG8_MMA(1, 0, At, B0); PG8_BAR; PG8_SCHED;
            PG8_STAGE(PG8_SB(1, 1), b3 + hstep, voffB);
            PG8_WAIT_V(6); PG8_BAR; PG8_MMA(1, 1, At, B1); PG8_BAR;
        }
        PG8_STAMP();
        if constexpr (!Epi::AFTER_DRAIN) { E(acc, cur, wr, wc, fr, fq); S.done(cur); }
        PG8_STAMP();
        if (!has_next) break;
#pragma unroll
        for (int a = 0; a < 2; ++a)
#pragma unroll
            for (int b = 0; b < 2; ++b)
#pragma unroll
                for (int m = 0; m < 4; ++m)
#pragma unroll
                    for (int n = 0; n < 2; ++n) acc[a][b][m][n] = (f32x4){0.f, 0.f, 0.f, 0.f};
        cur = nxt; cA = nA; cB = nB; ++ui;
    }
    PG8_WAIT_V(0);
    if (wr == 0) PG8_BAR;
    PG8_BAR;
    if constexpr (Epi::AFTER_DRAIN) { E.fused(acc, cur, wr, wc, fr, fq, lds, wid, lane); S.done(cur); }
    PG8_STAMP();
    if (STAMP && wid == 0) { stamps[lane] = lane < nts ? (((unsigned long long)(unsigned)ts_hi << 32) | (unsigned)ts_lo) : 0ull;
        if (lane == 62) stamps[62] = rt_entry; if (lane == 63) stamps[63] = (unsigned long long)wall_clock64(); }
#undef PG8_STAMP
#undef PG8_SA
#undef PG8_SB
#undef PG8_STAGE
#undef PG8_LDA
#undef PG8_LDB
#undef PG8_MMA
#undef PG8_WAIT_V
#undef PG8_WAIT_L
#undef PG8_BAR
#undef PG8_SCHED
}
}
namespace da {
constexpr int D = 128;
constexpr int LDI = 128, LDO = 2048;
constexpr float THR = 8.f;
constexpr bool WSKIP = false;
constexpr float SCALE = 0.08838834764831845f;
constexpr int NW = 8, QBLK = 32, KVBLK = 64, QB = NW * QBLK;
constexpr int SHM_V = KVBLK * D * 2, SHM_K = KVBLK * D * 2;
constexpr int LDS_BYTES = 2 * SHM_V + 2 * SHM_K + NW * 64 * 4;

using bf16 = __hip_bfloat16;
typedef short bf16x8 __attribute__((ext_vector_type(8)));
typedef short s16x4 __attribute__((ext_vector_type(4)));
typedef float f32x16 __attribute__((ext_vector_type(16)));
typedef float f32x4 __attribute__((ext_vector_type(4)));
typedef unsigned u32x4 __attribute__((ext_vector_type(4)));
template <class A, class Bt> struct same_t { static constexpr bool v = false; };
template <class A> struct same_t<A, A> { static constexpr bool v = true; };

#define KSWZ(row, colB) ((row) * 256 + ((colB) ^ (((row) & 7) << 4)))
#define SBAR() __builtin_amdgcn_sched_barrier(0)
__device__ __forceinline__ int v_st(int k, int c) { const int kk = (k & ~0xC) | ((k & 4) << 1) | ((k & 8) >> 1); return ((kk >> 3) * 4 + (c >> 5)) * 512 + ((kk & 7) * 32 + (c & 31)) * 2; }
__device__ __forceinline__ int v_rd_base(int lane) { return ((lane & 3) << 3) | (((lane >> 2) & 3) << 6) | (((lane >> 4) & 1) << 5) | (((lane >> 5) & 1) << 8); }
constexpr int v_rd_off(int d0, int ks, int half) { return d0 * 512 + ks * 4096 + half * 2048; }
__device__ __forceinline__ int crow(int r, int hi) { return (r & 3) + 8 * (r >> 2) + 4 * hi; }
__device__ __forceinline__ unsigned cvtpk(float lo, float hi) {
    unsigned r; asm volatile("v_cvt_pk_bf16_f32 %0, %1, %2" : "=v"(r) : "v"(lo), "v"(hi)); return r;
}
__device__ __forceinline__ bf16x8 pack8(f32x4 a, f32x4 b) {
    u32x4 w = {cvtpk(a[0], a[1]), cvtpk(a[2], a[3]), cvtpk(b[0], b[1]), cvtpk(b[2], b[3])};
    return *reinterpret_cast<bf16x8*>(&w);
}
template <class T> __device__ __forceinline__ bf16x8 load8(const T* p) {
    if constexpr (same_t<T, float>::v) { return pack8(*(const f32x4*)p, *(const f32x4*)(p + 4)); }
    else { return *reinterpret_cast<const bf16x8*>(p); }
}
__device__ __forceinline__ void mask_tile(f32x16& p0, f32x16& p1, int dq, unsigned W) {
    const float NEG = -__builtin_inff();
#pragma unroll
    for (int r = 0; r < 16; ++r) {
        const int c = (r & 3) + 8 * (r >> 2);
        if ((unsigned)(dq - c) >= W) p0[r] = NEG;
        if ((unsigned)(dq - c - 32) >= W) p1[r] = NEG;
    }
}
__device__ __forceinline__ void partialSM(f32x16& p0, f32x16& p1, float& m_reg, float& mn, float& alpha) {
    float pmax = p0[0]; for (int r = 1; r < 16; ++r) pmax = fmaxf(pmax, p0[r]); for (int r = 0; r < 16; ++r) pmax = fmaxf(pmax, p1[r]);
    { auto rr = __builtin_amdgcn_permlane32_swap(__float_as_uint(pmax), __float_as_uint(pmax), false, false);
      pmax = fmaxf(__uint_as_float(rr[0]), __uint_as_float(rr[1])); }
    constexpr float C2 = 1.4426950408889634f * SCALE;
    if (__builtin_expect(__all((pmax - m_reg) * SCALE <= THR), 1)) { mn = m_reg; alpha = 1.f; }
    else { mn = fmaxf(m_reg, pmax); alpha = __builtin_amdgcn_exp2f((m_reg - mn) * C2); m_reg = mn; }
    const float mnL = -mn * C2;
    for (int r = 0; r < 16; ++r) p0[r] = fmaf(p0[r], C2, mnL); for (int r = 0; r < 16; ++r) p1[r] = fmaf(p1[r], C2, mnL);
    for (int r = 0; r < 16; ++r) p0[r] = __builtin_amdgcn_exp2f(p0[r]);
}
__device__ __forceinline__ void finishSM(f32x16& p0, f32x16& p1, float alpha, float& l_reg, bf16x8& pa0, bf16x8& pa1, bf16x8& pa2, bf16x8& pa3) {
    for (int r = 0; r < 16; ++r) p1[r] = __builtin_amdgcn_exp2f(p1[r]);
    float ps = 0; for (int r = 0; r < 16; ++r) ps += p0[r]; for (int r = 0; r < 16; ++r) ps += p1[r];
    { auto rr = __builtin_amdgcn_permlane32_swap(__float_as_uint(ps), __float_as_uint(ps), false, false);
      ps = __uint_as_float(rr[0]) + __uint_as_float(rr[1]); }
    l_reg = l_reg * alpha + ps;
#define PK4(P, B_, OUT) do { unsigned a0 = cvtpk(P[B_+0], P[B_+1]), a1 = cvtpk(P[B_+2], P[B_+3]);                          \
        unsigned b0 = cvtpk(P[B_+4], P[B_+5]), b1 = cvtpk(P[B_+6], P[B_+7]);                                             \
        auto r0 = __builtin_amdgcn_permlane32_swap(a0, b0, false, false); auto r1 = __builtin_amdgcn_permlane32_swap(a1, b1, false, false); \
        u32x4 w = {r0[0], r1[0], r0[1], r1[1]}; OUT = *reinterpret_cast<bf16x8*>(&w); } while (0)
    PK4(p0, 0, pa0); PK4(p0, 8, pa1); PK4(p1, 0, pa2); PK4(p1, 8, pa3);
#undef PK4
}
template <int KB, bool SK>
__device__ __forceinline__ void qkt(f32x16& p0, f32x16& p1, const char* K_lds, int r32, int hi, const bf16x8* qr, bool act) {
    if (SK && !act) { const float NEG = -__builtin_inff();
#pragma unroll
        for (int r = 0; r < 16; ++r) { p0[r] = NEG; p1[r] = NEG; } return; }
    p0 = f32x16{}; p1 = f32x16{};
    const char* kb[4];
#pragma unroll
    for (int dd = 0; dd < 4; ++dd) kb[dd] = K_lds + KB * SHM_K + KSWZ(r32, (dd * 16 + hi * 8) * 2);
#pragma unroll
    for (int d0 = 0; d0 < 8; ++d0) { const char* a = kb[d0 & 3] + (d0 >> 2) * 128;
        bf16x8 b0 = *reinterpret_cast<const bf16x8*>(a);
        bf16x8 b1 = *reinterpret_cast<const bf16x8*>(a + 32 * 256);
        p0 = __builtin_amdgcn_mfma_f32_32x32x16_bf16(b0, qr[d0], p0, 0, 0, 0);
        p1 = __builtin_amdgcn_mfma_f32_32x32x16_bf16(b1, qr[d0], p1, 0, 0, 0); }
}
template <int VB, bool SK>
__device__ __forceinline__ void pv_tile(f32x16* o, int vb0, bf16x8 pa0, bf16x8 pa1, bf16x8 pa2, bf16x8 pa3, bool act) {
    if (SK && !act) return;
#define TRRD(dst, off) asm volatile("ds_read_b64_tr_b16 %0, %1 offset:%2" : "=&v"(dst) : "v"(vb0), "i"(off) : "memory")
#define PV_D0(d0) do { s16x4 l0, l1, l2, l3, h0, h1, h2, h3; constexpr int b_ = VB * SHM_V + v_rd_off(d0, 0, 0);     \
        TRRD(l0, b_); TRRD(h0, b_ + 2048); TRRD(l1, b_ + 4096); TRRD(h1, b_ + 6144); TRRD(l2, b_ + 8192); TRRD(h2, b_ + 10240); TRRD(l3, b_ + 12288); TRRD(h3, b_ + 14336); \
        asm volatile("s_waitcnt lgkmcnt(0)" ::: "memory"); SBAR();                 \
        o[d0] = __builtin_amdgcn_mfma_f32_32x32x16_bf16(pa0, (bf16x8){l0[0], l0[1], l0[2], l0[3], h0[0], h0[1], h0[2], h0[3]}, o[d0], 0, 0, 0);   \
        o[d0] = __builtin_amdgcn_mfma_f32_32x32x16_bf16(pa1, (bf16x8){l1[0], l1[1], l1[2], l1[3], h1[0], h1[1], h1[2], h1[3]}, o[d0], 0, 0, 0);   \
        o[d0] = __builtin_amdgcn_mfma_f32_32x32x16_bf16(pa2, (bf16x8){l2[0], l2[1], l2[2], l2[3], h2[0], h2[1], h2[2], h2[3]}, o[d0], 0, 0, 0);   \
        o[d0] = __builtin_amdgcn_mfma_f32_32x32x16_bf16(pa3, (bf16x8){l3[0], l3[1], l3[2], l3[3], h3[0], h3[1], h3[2], h3[3]}, o[d0], 0, 0, 0); } while (0)
    PV_D0(0); PV_D0(1); PV_D0(2); PV_D0(3);
#undef PV_D0
#undef TRRD
}

template <class TIn, class TOut> struct BlockRef { const TIn* Q; const TIn* K; const TIn* V; TOut* O; int P0; };
template <class TIn> struct Seam {
    bf16x8 qr[8];
    bf16x8 st_v0, st_v1, st_k0, st_k1; f32x4 sf0, sf1, sf2, sf3;
    f32x4 tq[16];
};
__device__ __forceinline__ int swa_jlo(int P0, int W) { const int lowk = P0 - W + 1; return lowk > 0 ? lowk / KVBLK : 0; }
#define ROW(p, k0, rr) ((p) + (size_t)((k0) + (rr)) * LDI + sc)
#define VMW() asm volatile("s_waitcnt vmcnt(0)" ::: "memory")
#define VMWN(n) asm volatile("s_waitcnt vmcnt(%0)" :: "i"(n) : "memory")
#define SLOAD_H(Kp, Vp, k0) do { S.st_v0 = load8<TIn>(ROW(Vp, k0, sr)); S.st_v1 = load8<TIn>(ROW(Vp, k0, 32 + sr));              \
                         S.st_k0 = load8<TIn>(ROW(Kp, k0, sr)); S.st_k1 = load8<TIn>(ROW(Kp, k0, 32 + sr)); } while (0)
#define SWRITE_HK(bf) do { *(bf16x8*)(K_lds + (bf) * SHM_K + kws) = S.st_k0; *(bf16x8*)(K_lds + (bf) * SHM_K + kws + 32 * 256) = S.st_k1; } while (0)
#define SWRITE_HV(bf) do { *(bf16x8*)(V_lds + (bf) * SHM_V + vst0) = S.st_v0; *(bf16x8*)(V_lds + (bf) * SHM_V + vst1) = S.st_v1; } while (0)
#define SWRITE_H(bf) do { SWRITE_HV(bf); SWRITE_HK(bf); } while (0)
#define SLOAD_F(p, k0) do { S.sf0 = *(const f32x4*)ROW(p, k0, sr); S.sf1 = *(const f32x4*)(ROW(p, k0, sr) + 4);                \
                            S.sf2 = *(const f32x4*)ROW(p, k0, 32 + sr); S.sf3 = *(const f32x4*)(ROW(p, k0, 32 + sr) + 4); } while (0)
#define SWRITE_KF(bf) do { *(bf16x8*)(K_lds + (bf) * SHM_K + kws) = pack8(S.sf0, S.sf1); *(bf16x8*)(K_lds + (bf) * SHM_K + kws + 32 * 256) = pack8(S.sf2, S.sf3); } while (0)
#define SWRITE_VF(bf) do { *(bf16x8*)(V_lds + (bf) * SHM_V + vst0) = pack8(S.sf0, S.sf1); *(bf16x8*)(V_lds + (bf) * SHM_V + vst1) = pack8(S.sf2, S.sf3); } while (0)
template <class TIn, class TOut>
__device__ __forceinline__ void causal_swa_prime(const BlockRef<TIn, TOut>& cur, int W, char* lds, Seam<TIn>& S) {
    constexpr bool F32 = same_t<TIn, float>::v;
    const int tid = opq_tid(), wid = __builtin_amdgcn_readfirstlane(tid >> 6), lane = tid & 63, r32 = lane & 31, hi = lane >> 5;
    const int sr = tid >> 4, sc = (tid & 15) * 8, kws = KSWZ(sr, sc * 2); char* K_lds = lds + 2 * SHM_V;
    const int kb0 = swa_jlo(cur.P0, W) * KVBLK;
    for (int d0 = 0; d0 < 8; ++d0) S.qr[d0] = load8<TIn>(cur.Q + (size_t)(wid * QBLK + r32) * LDI + d0 * 16 + hi * 8);
    if constexpr (F32) { SLOAD_F((const float*)cur.K, kb0); VMW(); SWRITE_KF(0); SBAR(); SLOAD_F((const float*)cur.V, kb0); }
    else { SLOAD_H(cur.K, cur.V, kb0); VMW(); SWRITE_HK(0); }
    __syncthreads();
}
template <class TIn, class TOut>
__device__ __forceinline__ void causal_swa_block(const BlockRef<TIn, TOut>& cur, const BlockRef<TIn, TOut>& nxt, int skv, int W, char* lds, Seam<TIn>& S) {
    constexpr bool F32 = same_t<TIn, float>::v;
    const int tid = opq_tid(), wid = __builtin_amdgcn_readfirstlane(tid >> 6), lane = tid & 63, r32 = lane & 31, hi = lane >> 5;
    const int j_lo = swa_jlo(cur.P0, W);
    int j_hi = (cur.P0 + QB - 1) / KVBLK + 1; if (j_hi > skv / KVBLK) j_hi = skv / KVBLK;
    const int NT = j_hi - j_lo;
    const int kbn = swa_jlo(nxt.P0, W) * KVBLK;
    const int qlo = cur.P0 + wid * QBLK, qm = qlo + r32 - 4 * hi;
    char* V_lds = lds; char* K_lds = lds + 2 * SHM_V;
    float* ws = (float*)(lds + 2 * SHM_V + 2 * SHM_K) + wid * 64; float* li_l = ws, * al_l = ws + 32;
    float m_reg = -1e30f, l_reg = 0; f32x16 o[4] = {};
    const int sr = tid >> 4, sc = (tid & 15) * 8, vst0 = v_st(sr, sc), vst1 = v_st(32 + sr, sc), kws = KSWZ(sr, sc * 2);
    const int vb0 = (int)(uintptr_t)V_lds + v_rd_base(lane);
    const TIn* Kh = cur.K; const TIn* Vh = cur.V;
#define RESC(a) do { if (__any((a) < 1.f)) { if (hi == 0) al_l[r32] = (a); asm volatile("s_waitcnt lgkmcnt(0)" ::: "memory");              \
                     for (int d_ = 0; d_ < 4; ++d_) for (int r = 0; r < 16; ++r) o[d_][r] *= al_l[crow(r, hi)]; } } while (0)
#define KBASE(t) ((j_lo + (t)) * KVBLK)
#define ACT(t) (KBASE(t) <= qlo + QBLK - 1 && KBASE(t) + KVBLK - 1 >= qlo - W + 1)
#define MASKT(P0_, P1_, t) do { const int kb_ = KBASE(t); if ((!SK || ACT(t)) && (kb_ + KVBLK - 1 > qlo || kb_ <= qlo + QBLK - 1 - W)) mask_tile(P0_, P1_, qm - kb_, (unsigned)W); } while (0)
    constexpr int NQL = F32 ? 16 : 8;
    constexpr bool SK = WSKIP && !F32;
#define SEAM_K0() do { VMWN(NQL); if constexpr (F32) { SWRITE_KF(0); SBAR(); SLOAD_F((const float*)nxt.V, kbn); } else { SWRITE_HK(0); } SBAR(); } while (0)
    f32x16 pA0, pA1, pB0, pB1; float mnA, mnB, alA, alB; bf16x8 pa0, pa1, pa2, pa3;
    if constexpr (F32) { VMW(); SWRITE_VF(0); SBAR(); } else { SWRITE_HV(0); SBAR(); }
    if (NT > 1) { if constexpr (F32) SLOAD_F((const float*)Kh, KBASE(1)); else SLOAD_H(Kh, Vh, KBASE(1)); }
    SBAR(); qkt<0, SK>(pA0, pA1, K_lds, r32, hi, S.qr, ACT(0));
    if constexpr (F32) { if (NT > 1) { VMW(); SWRITE_KF(1); SBAR(); SLOAD_F((const float*)Vh, KBASE(1)); } }
    MASKT(pA0, pA1, 0); partialSM(pA0, pA1, m_reg, mnA, alA);
    if (NT > 1) { VMW(); if constexpr (F32) { SWRITE_VF(1); SBAR(); if (NT > 2) SLOAD_F((const float*)Kh, KBASE(2)); } else SWRITE_H(1); }
    __syncthreads();
#define HALF_STEP(PX0, PX1, mnX, alX, PY0, PY1, alY, t, KB, VB, SB) do {                                                      \
        SBAR(); qkt<KB, SK>(PX0, PX1, K_lds, r32, hi, S.qr, ACT(t));                                             \
        finishSM(PY0, PY1, alY, l_reg, pa0, pa1, pa2, pa3); SBAR();                                                           \
        if ((t) + 1 < NT) { if constexpr (F32) { VMW(); SWRITE_KF(SB); SBAR(); SLOAD_F((const float*)Vh, KBASE((t) + 1)); }  \
                            else { SLOAD_H(Kh, Vh, KBASE((t) + 1)); } SBAR(); }                                               \
        pv_tile<VB, SK>(o, vb0, pa0, pa1, pa2, pa3, ACT((t) - 1)); MASKT(PX0, PX1, (t)); partialSM(PX0, PX1, m_reg, mnX, alX);                                        \
        __syncthreads();                                                                                                      \
        if ((t) + 1 < NT) { VMW(); if constexpr (F32) { SWRITE_VF(SB); SBAR(); if ((t) + 2 < NT) SLOAD_F((const float*)Kh, KBASE((t) + 2)); } \
                            else { SWRITE_H(SB); } }                                                                          \
        RESC(alX); __syncthreads(); } while (0)
    for (int t = 1; t + 1 < NT; t += 2) {
        HALF_STEP(pB0, pB1, mnB, alB, pA0, pA1, alA, t, 1, 0, 0);
        HALF_STEP(pA0, pA1, mnA, alA, pB0, pB1, alB, t + 1, 0, 1, 1);
    }
    const bool even = (NT & 1) == 0;
    if (even) { SBAR(); qkt<1, SK>(pB0, pB1, K_lds, r32, hi, S.qr, ACT(NT - 1)); SBAR(); }
#define QROW(e) (nxt.Q + (size_t)(wid * QBLK + r32) * LDI + ((e) >> 1) * 16 + hi * 8 + ((e) & 1) * 4)
    if constexpr (F32) { SLOAD_F((const float*)nxt.K, kbn); SBAR();
#pragma unroll
        for (int e = 0; e < 8; ++e) S.tq[e] = *(const f32x4*)QROW(e); }
    else { SLOAD_H(nxt.K, nxt.V, kbn); SBAR();
#pragma unroll
        for (int d0 = 0; d0 < 8; ++d0) S.qr[d0] = load8<TIn>(nxt.Q + (size_t)(wid * QBLK + r32) * LDI + d0 * 16 + hi * 8); }
    SBAR();
    finishSM(pA0, pA1, alA, l_reg, pa0, pa1, pa2, pa3); SBAR();
    if constexpr (F32) {
#pragma unroll
        for (int e = 8; e < 16; ++e) S.tq[e] = *(const f32x4*)QROW(e); SBAR(); }
#undef QROW
    pv_tile<0, SK>(o, vb0, pa0, pa1, pa2, pa3, ACT(even ? NT - 2 : NT - 1));
    if (even) { MASKT(pB0, pB1, NT - 1); partialSM(pB0, pB1, m_reg, mnB, alB); __syncthreads(); RESC(alB);
        finishSM(pB0, pB1, alB, l_reg, pa0, pa1, pa2, pa3); SBAR(); pv_tile<1, SK>(o, vb0, pa0, pa1, pa2, pa3, ACT(NT - 1)); }
    SBAR(); SEAM_K0();
    if (hi == 0) li_l[r32] = l_reg; asm volatile("s_waitcnt lgkmcnt(0)" ::: "memory");
    float rli[16];
#pragma unroll
    for (int r = 0; r < 16; ++r) rli[r] = __builtin_amdgcn_rcpf(li_l[crow(r, hi)]);
    TOut* Ow = cur.O + (size_t)(wid * QBLK) * LDO;
#pragma unroll
    for (int r = 0; r < 16; ++r) { const int orow = crow(r, hi);
#pragma unroll
        for (int d0 = 0; d0 < 4; ++d0) { const float v = o[d0][r] * rli[r];
            if constexpr (same_t<TOut, float>::v) { Ow[(size_t)orow * LDO + d0 * 32 + r32] = v; }
            else { const float vn = __shfl_xor(v, 1);
                   if ((r32 & 1) == 0) *(unsigned*)(Ow + (size_t)orow * LDO + d0 * 32 + r32) = cvtpk(v, vn); } } }
    if constexpr (F32) {
#pragma unroll
        for (int d0 = 0; d0 < 8; ++d0) S.qr[d0] = pack8(S.tq[2 * d0], S.tq[2 * d0 + 1]); }
    __syncthreads();
#undef RESC
#undef KBASE
#undef ACT
#undef MASKT
#undef SEAM_K0
#undef HALF_STEP
}
#undef ROW
#undef VMW
#undef VMWN
#undef SLOAD_H
#undef SWRITE_HK
#undef SWRITE_HV
#undef SWRITE_H
#undef SLOAD_F
#undef SWRITE_KF
#undef SWRITE_VF
}

typedef unsigned short u16;
typedef short bf16x8_t __attribute__((ext_vector_type(8)));
typedef float f32x4_t __attribute__((ext_vector_type(4)));
typedef unsigned u32x4_t __attribute__((ext_vector_type(4)));

constexpr int T_ = 16384, S_ = 4096, DM = 2048, DFF = 5504, NGU = 11008, NPJ = 7168, PW = 7176;
constexpr int NTHR = 512;
constexpr size_t PBLK = (size_t)T_ * 128;
constexpr int LDT = 136;

constexpr size_t OFF_TAB = 0;
constexpr size_t SZ_TAB = (size_t)4096 * 64 * 4 * 2 + (size_t)4096 * 16 * 4 * 2;
constexpr size_t OFF_WGU1 = OFF_TAB + SZ_TAB;
constexpr size_t SZ_WGU = (size_t)NGU * DM * 2;
constexpr size_t OFF_WD1 = OFF_WGU1 + SZ_WGU;
constexpr size_t SZ_WD = (size_t)DM * DFF * 2;
constexpr size_t OFF_WIN = OFF_WD1 + SZ_WD;
constexpr size_t SZ_WIN = (size_t)NPJ * DM * 2;
constexpr size_t OFF_WOUT = OFF_WIN + SZ_WIN;
constexpr size_t SZ_WOUT = (size_t)DM * DM * 2;
constexpr size_t OFF_WGU2 = OFF_WOUT + SZ_WOUT;
constexpr size_t OFF_WD2 = OFF_WGU2 + SZ_WGU;
constexpr size_t OFF_XB = OFF_WD2 + SZ_WD;
constexpr size_t SZ_XB = (size_t)T_ * DM * 2;
constexpr size_t OFF_HP = OFF_XB + SZ_XB;
constexpr size_t SZ_HP = (size_t)T_ * NPJ * 2;
constexpr size_t OFF_Z = OFF_HP + SZ_HP;
constexpr size_t SZ_Z = (size_t)T_ * DM * 4;
constexpr size_t OFF_GATE = OFF_Z + SZ_Z;
constexpr size_t SZ_GATE = (size_t)T_ * 8 * 4;
constexpr size_t OFF_MQK = OFF_GATE + SZ_GATE;
constexpr size_t SZ_MQK = (size_t)T_ * 1024 * 2;
constexpr size_t OFF_STR = OFF_MQK + SZ_MQK;
constexpr size_t SZ_STR = (size_t)16 * 32 * 16384 * 4;
constexpr size_t OFF_STM = OFF_STR + SZ_STR;
constexpr size_t SZ_STM = (size_t)16 * 64 * 16384 * 4;
constexpr size_t OFF_NM = OFF_STM + SZ_STM;
constexpr size_t SZ_NM = (size_t)16 * 64 * 128 * 4;
constexpr size_t OFF_SC = OFF_NM + SZ_NM;
constexpr size_t SZ_SC = (size_t)16 * 64 * 4 * 4;
constexpr size_t OFF_MIX = OFF_SC + SZ_SC;
constexpr size_t SZ_MIX = (size_t)T_ * DM * 2;
constexpr size_t OFF_STAT = OFF_MIX + SZ_MIX;
constexpr size_t SZ_STAT = (size_t)6 * T_ * 2 * 4;
constexpr size_t OFF_CS = OFF_STAT + SZ_STAT;
constexpr int CS_LAYER = 2 * NPJ + 4 * NGU;
constexpr size_t SZ_CS = (size_t)2 * CS_LAYER * 4;
constexpr size_t OFF_BAR = OFF_CS + SZ_CS;
constexpr size_t SZ_BAR = 16384;
constexpr size_t WS_END = OFF_BAR + SZ_BAR;

constexpr int LDS_PHASE = 4 * 128 * LDT * 2 + 7 * 128 * 4;
constexpr int LDS_TOTAL = LDS_PHASE + 16;

struct Params { const float* in[16]; float* out; unsigned char* ws; };

__device__ __forceinline__ u16 f2bf(float f) { return (u16)(pg8::cvt_pk_bf16(f, 0.f) & 0xffffu); }
__device__ __forceinline__ float bf2f(u16 b) { return __uint_as_float(((unsigned)b) << 16); }
__device__ __forceinline__ unsigned pk2(float a, float b) { return pg8::cvt_pk_bf16(a, b); }
__device__ __forceinline__ float shx(float v, int o, int lane) { return __int_as_float(__builtin_amdgcn_ds_bpermute((lane ^ o) << 2, __float_as_int(v))); }
__device__ __forceinline__ float shup(float v, int o, int lane) { return __int_as_float(__builtin_amdgcn_ds_bpermute(((lane - o) & 63) << 2, __float_as_int(v))); }
__device__ __forceinline__ float dpp_f(float v, int ctrl_sel) {
    const int x = __float_as_int(v);
    int r;
    if (ctrl_sel == 0) r = __builtin_amdgcn_update_dpp(x, x, 0xB1, 0xF, 0xF, false);
    else if (ctrl_sel == 1) r = __builtin_amdgcn_update_dpp(x, x, 0x4E, 0xF, 0xF, false);
    else if (ctrl_sel == 2) r = __builtin_amdgcn_update_dpp(x, x, 0x124, 0xF, 0xF, false);
    else r = __builtin_amdgcn_update_dpp(x, x, 0x128, 0xF, 0xF, false);
    return __int_as_float(r);
}
__device__ __forceinline__ float wave_sum(float v, int lane) {
    (void)lane;
    v += dpp_f(v, 0); v += dpp_f(v, 1); v += dpp_f(v, 2); v += dpp_f(v, 3);
    const int x = __float_as_int(v);
    return (__int_as_float(__builtin_amdgcn_readlane(x, 0)) + __int_as_float(__builtin_amdgcn_readlane(x, 16))) + (__int_as_float(__builtin_amdgcn_readlane(x, 32)) + __int_as_float(__builtin_amdgcn_readlane(x, 48)));
}
__device__ __forceinline__ float wave_max(float v, int lane) {
    (void)lane;
    v = fmaxf(v, dpp_f(v, 0)); v = fmaxf(v, dpp_f(v, 1)); v = fmaxf(v, dpp_f(v, 2)); v = fmaxf(v, dpp_f(v, 3));
    const int x = __float_as_int(v);
    return fmaxf(fmaxf(__int_as_float(__builtin_amdgcn_readlane(x, 0)), __int_as_float(__builtin_amdgcn_readlane(x, 16))), fmaxf(__int_as_float(__builtin_amdgcn_readlane(x, 32)), __int_as_float(__builtin_amdgcn_readlane(x, 48))));
}
__device__ __forceinline__ float scan_sum(float v, int lane) {
#pragma unroll
    for (int o = 1; o < 64; o <<= 1) { const float t = shup(v, o, lane); if (lane >= o) v += t; }
    return v;
}
__device__ __forceinline__ float scan_max(float v, int lane) {
#pragma unroll
    for (int o = 1; o < 64; o <<= 1) { const float t = shup(v, o, lane); if (lane >= o) v = fmaxf(v, t); }
    return v;
}
__device__ __forceinline__ float silu_f(float x) { return x * __builtin_amdgcn_rcpf(1.0f + __expf(-x)); }
__device__ __forceinline__ float sigmoid_f(float x) { return __builtin_amdgcn_rcpf(1.0f + __expf(-x)); }
__device__ __forceinline__ float log1p01(float e) {
    const float s = e / (2.0f + e), s2 = s * s;
    return 2.0f * s * (1.0f + s2 * (0.333333333f + s2 * (0.2f + s2 * (0.142857143f + s2 * (0.111111111f + s2 * 0.0909090909f)))));
}
__device__ __forceinline__ float logsig_f(float x) { return x >= 0.f ? -log1p01(__expf(-x)) : x - log1p01(__expf(x)); }
__device__ __forceinline__ float ret_logg(int h) {
    return h == 0 ? -0.031748698314580301f : (h == 1 ? -0.015748356968139168f : (h == 2 ? -0.0078431774610258787f : -0.0039138993211363287f));
}

__device__ __forceinline__ void phase_init(const Params& p) {
    const int gtid = opq_bid() * NTHR + opq_tid(), gn = opq_gdim() * NTHR;
    float* retc = (float*)(p.ws + OFF_TAB); float* rets = retc + 4096 * 64; float* difc = rets + 4096 * 64; float* difs = difc + 4096 * 16;
    for (int i = gtid; i < 4096 * 64; i += gn) {
        const int pos = i >> 6, j = i & 63; const float inv = powf(10000.0f, -(float)(2 * j) / 128.0f); const float ang = (float)pos * inv;
        retc[i] = cosf(ang); rets[i] = sinf(ang); }
    for (int i = gtid; i < 4096 * 16; i += gn) {
        const int pos = i >> 4, j = i & 15; const float inv = powf(500000.0f, -(float)(2 * j) / 32.0f); const float ang = (float)pos * inv;
        difc[i] = cosf(ang); difs[i] = sinf(ang); }
    const float4* x4 = (const float4*)p.in[0]; uint2* xb = (uint2*)(p.ws + OFF_XB);
    for (int i0 = gtid; i0 < T_ * DM / 4; i0 += 4 * gn) {
        float4 v[4];
#pragma unroll
        for (int e = 0; e < 4; ++e) v[e] = (i0 + e * gn < T_ * DM / 4) ? x4[i0 + e * gn] : make_float4(0.f, 0.f, 0.f, 0.f);
#pragma unroll
        for (int e = 0; e < 4; ++e) if (i0 + e * gn < T_ * DM / 4) { uint2 w; w.x = pk2(v[e].x, v[e].y); w.y = pk2(v[e].z, v[e].w); xb[i0 + e * gn] = w; }
    }
    float* zero = (float*)(p.ws + OFF_CS);
    for (int i = gtid; i < (int)(SZ_CS / 4); i += gn) zero[i] = 0.f;
}

__device__ __forceinline__ int win_row(int n) {
    const int pn = n >> 8, c = n & 255, g = c >> 7, j = c & 127;
    if (pn < 4) return 256 * pn + 128 * (j >> 6) + 64 * g + (j & 63);
    if (pn >= 8 && pn < 16) {
        if (j < 16) return 256 * pn + 16 * g + j;
        if (j < 32) return 256 * pn + 128 + 16 * g + (j - 16);
        if (j < 80) return 256 * pn + 32 + 48 * g + (j - 32);
        return 256 * pn + 128 + 32 + 48 * g + (j - 80);
    }
    return n;
}
template <int MODE>
__device__ __forceinline__ void convert_T(const float* __restrict__ W, int K, int ldn, int ncols, u16* __restrict__ Wt, float* tile) {
    const int tk = K / 64, tn = ncols / 64, nt = tk * tn, t = opq_tid();
    const int per = (nt + opq_gdim() - 1) / opq_gdim(), t0 = opq_bid() * per, t1 = (t0 + per < nt) ? t0 + per : nt;
    if (t0 >= t1) return;
    const int lr = t >> 4, lc = (t & 15) * 4;
    const int nn = t >> 3, k8 = (t & 7) * 8;
    f32x4_t ra[4], rb[4];
#define CT_LOAD(d, tix) do { const int k_ = ((tix) / tn) * 64, n_ = ((tix) % tn) * 64; const float* s_ = W + (size_t)(k_ + lr) * ldn + n_ + lc; ra[d] = *(const f32x4_t*)s_; rb[d] = *(const f32x4_t*)(s_ + (size_t)32 * ldn); } while (0)
    CT_LOAD(0, t0);
    if (t0 + 1 < t1) CT_LOAD(1, t0 + 1);
    if (t0 + 2 < t1) CT_LOAD(2, t0 + 2);
    for (int ti = t0; ti < t1; ++ti) {
        const int k0 = (ti / tn) * 64, n0 = (ti % tn) * 64;
        if (ti + 3 < t1) CT_LOAD(3, ti + 3);
        __syncthreads();
#pragma unroll
        for (int e = 0; e < 4; ++e) { tile[lr * 65 + lc + e] = ra[0][e]; tile[(lr + 32) * 65 + lc + e] = rb[0][e]; }
        __syncthreads();
        float wv[8];
#pragma unroll
        for (int j = 0; j < 8; ++j) wv[j] = tile[(k8 + j) * 65 + nn];
        const int n = n0 + nn;
        const int row = MODE == 0 ? n : (MODE == 1 ? (256 * ((n % DFF) / 128) + 128 * (n / DFF) + (n % 128)) : win_row(n));
        uint4 w; w.x = pk2(wv[0], wv[1]); w.y = pk2(wv[2], wv[3]); w.z = pk2(wv[4], wv[5]); w.w = pk2(wv[6], wv[7]);
        *(uint4*)(Wt + (size_t)row * K + k0 + k8) = w;
#pragma unroll
        for (int d = 0; d < 3; ++d) { ra[d] = ra[d + 1]; rb[d] = rb[d + 1]; }
    }
#undef CT_LOAD
}
__device__ __forceinline__ void phase_weights(const Params& p, int l, unsigned char* lds) {
    float* tile = (float*)lds;
    convert_T<1>(p.in[3] + (size_t)l * DM * NGU, DM, NGU, NGU, (u16*)(p.ws + OFF_WGU1), tile);
    convert_T<0>(p.in[4] + (size_t)l * DFF * DM, DFF, DM, DM, (u16*)(p.ws + OFF_WD1), tile);
    convert_T<2>(p.in[5] + (size_t)l * DM * PW, DM, PW, NPJ, (u16*)(p.ws + OFF_WIN), tile);
    convert_T<0>(p.in[13] + (size_t)l * DM * DM, DM, DM, DM, (u16*)(p.ws + OFF_WOUT), tile);
    convert_T<1>(p.in[14] + (size_t)l * DM * NGU, DM, NGU, NGU, (u16*)(p.ws + OFF_WGU2), tile);
    convert_T<0>(p.in[15] + (size_t)l * DFF * DM, DFF, DM, DM, (u16*)(p.ws + OFF_WD2), tile);
}

__device__ __forceinline__ void row_mr(const float* st, int row, float& mean, float& rstd) { const float2 v = *(const float2*)(st + (size_t)row * 2); mean = v.x; rstd = v.y; }
struct EpiSwiGLU {
    static constexpr bool PERM = true, AFTER_DRAIN = false;
    u16* H;
    __device__ __forceinline__ void operator()(const pg8::f32x4 (&acc)[2][2][4][2], const pg8::Unit& u, int wr, int wc, int fr, int fq) const {
        const int row0 = u.pm * 256 + wr * 64 + fr, col0 = u.pn * 128 + wc * 32 + 8 * fq;
#pragma unroll
        for (int ai = 0; ai < 2; ++ai)
#pragma unroll
            for (int m = 0; m < 4; ++m) {
                u16* rowp = H + (size_t)(row0 + ai * 128 + m * 16) * DFF + col0;
                const pg8::f32x4 g0 = acc[ai][0][m][0], g1 = acc[ai][0][m][1], u0 = acc[ai][1][m][0], u1 = acc[ai][1][m][1];
                float h[8];
#pragma unroll
                for (int j = 0; j < 4; ++j) { h[j] = silu_f(g0[j]) * u0[j]; h[4 + j] = silu_f(g1[j]) * u1[j]; }
                pg8::u32x4 w; w.x = pg8::cvt_pk_bf16(h[0], h[1]); w.y = pg8::cvt_pk_bf16(h[2], h[3]); w.z = pg8::cvt_pk_bf16(h[4], h[5]); w.w = pg8::cvt_pk_bf16(h[6], h[7]);
                *(pg8::u32x4*)rowp = w;
            }
    }
};
struct EpiProjBM {
    static constexpr bool PERM = true, AFTER_DRAIN = false;
    u16* O; const float* tab;
    __device__ __forceinline__ static void st8(u16* p, const pg8::f32x4& a, const pg8::f32x4& b) {
        pg8::u32x4 w; w.x = pg8::cvt_pk_bf16(a[0], a[1]); w.y = pg8::cvt_pk_bf16(a[2], a[3]); w.z = pg8::cvt_pk_bf16(b[0], b[1]); w.w = pg8::cvt_pk_bf16(b[2], b[3]);
        *(pg8::u32x4*)p = w;
    }
    __device__ __forceinline__ void operator()(const pg8::f32x4 (&acc)[2][2][4][2], const pg8::Unit& u, int wr, int wc, int fr, int fq) const {
        const int row0 = u.pm * 256 + wr * 64 + fr, x0 = wc * 32 + 8 * fq;
        const bool ret_u = u.pn < 4, dif_u = u.pn >= 8 && u.pn < 16;
        if (ret_u) {
            const int head = x0 >> 6, jj = x0 & 63; const float sc = u.pn >= 2 ? 0.08838834764831845f : 1.0f;
            u16* blk = O + (size_t)(2 * u.pn + head) * PBLK + jj;
#pragma unroll
            for (int ai = 0; ai < 2; ++ai)
#pragma unroll
                for (int m = 0; m < 4; ++m) {
                    const int row = row0 + ai * 128 + m * 16; const float* ct = tab + (size_t)(row & 4095) * 64 + jj; const float* st = ct + 4096 * 64;
                    const pg8::f32x4 c0 = *(const pg8::f32x4*)ct, c1 = *(const pg8::f32x4*)(ct + 4), s0 = *(const pg8::f32x4*)st, s1 = *(const pg8::f32x4*)(st + 4);
                    const pg8::f32x4 a0 = acc[ai][0][m][0], a1 = acc[ai][0][m][1], b0 = acc[ai][1][m][0], b1 = acc[ai][1][m][1];
                    st8(blk + (size_t)row * 128, (a0 * c0 - b0 * s0) * sc, (a1 * c1 - b1 * s1) * sc);
                    st8(blk + (size_t)row * 128 + 64, (a0 * s0 + b0 * c0) * sc, (a1 * s1 + b1 * c1) * sc);
                }
        } else if (dif_u && wc == 0) {
            const int g = x0 >> 4, jj = x0 & 15;
            u16* blk = O + (size_t)(2 * u.pn + g) * PBLK + jj;
            const float* dtab = tab + 2 * 4096 * 64;
#pragma unroll
            for (int ai = 0; ai < 2; ++ai)
#pragma unroll
                for (int m = 0; m < 4; ++m) {
                    const int row = row0 + ai * 128 + m * 16; const float* ct = dtab + (size_t)(row & 4095) * 16 + jj; const float* st = ct + 4096 * 16;
                    const pg8::f32x4 c0 = *(const pg8::f32x4*)ct, c1 = *(const pg8::f32x4*)(ct + 4), s0 = *(const pg8::f32x4*)st, s1 = *(const pg8::f32x4*)(st + 4);
                    const pg8::f32x4 a0 = acc[ai][0][m][0], a1 = acc[ai][0][m][1], b0 = acc[ai][1][m][0], b1 = acc[ai][1][m][1];
                    st8(blk + (size_t)row * 128, a0 * c0 - b0 * s0, a1 * c1 - b1 * s1);
                    st8(blk + (size_t)row * 128 + 16, a0 * s0 + b0 * c0, a1 * s1 + b1 * c1);
                }
        } else {
#pragma unroll
            for (int bj = 0; bj < 2; ++bj) {
                int blkid = 2 * u.pn + bj, col = x0;
                if (dif_u) { const int g = x0 >= 80; blkid = 2 * u.pn + g; col = (bj == 0) ? (g ? x0 - 48 : x0) : (g ? x0 : x0 + 48); }
                u16* blk = O + (size_t)blkid * PBLK + col;
#pragma unroll
                for (int ai = 0; ai < 2; ++ai)
#pragma unroll
                    for (int m = 0; m < 4; ++m) st8(blk + (size_t)(row0 + ai * 128 + m * 16) * 128, acc[ai][bj][m][0], acc[ai][bj][m][1]);
            }
        }
    }
};
struct EpiResid {
    static constexpr bool PERM = false, AFTER_DRAIN = false;
    const float* Zp; const float* pst; const float* pg; const float* pb; float* Z; float alpha, s;
    __device__ __forceinline__ void operator()(const pg8::f32x4 (&acc)[2][2][4][2], const pg8::Unit& u, int wr, int wc, int fr, int fq) const {
        const int row0 = u.pm * 256 + wr * 64 + fr, col0 = u.pn * 256 + wc * 32 + 4 * fq;
#pragma unroll
        for (int ai = 0; ai < 2; ++ai)
#pragma unroll
            for (int m = 0; m < 4; ++m) {
                const int row = row0 + ai * 128 + m * 16;
                float mean = 0.f, rstd = 1.f; if (pst) row_mr(pst, row, mean, rstd);
                const size_t off = (size_t)row * DM + col0;
#pragma unroll
                for (int bj = 0; bj < 2; ++bj)
#pragma unroll
                    for (int n = 0; n < 2; ++n) {
                        const int co = bj * 128 + n * 16;
                        pg8::f32x4 xv = *(const pg8::f32x4*)(Zp + off + co);
                        if (pst) { const pg8::f32x4 gv = *(const pg8::f32x4*)(pg + col0 + co), bv = *(const pg8::f32x4*)(pb + col0 + co); xv = (xv - mean) * rstd * gv + bv; }
                        const pg8::f32x4 z = xv * alpha + acc[ai][bj][m][n] * s;
                        *(pg8::f32x4*)(Z + off + co) = z;
                    }
            }
    }
};
template <class Epi>
__device__ __forceinline__ void run_gemm(unsigned char* lds, const u16* A, const u16* Bt, int M, int N, int K, const Epi& E) {
    pg8::Gemm g; g.A = A; g.Bt = Bt; g.M = M; g.N = N; g.K = K;
    pg8::StaticOrder S; S.init(M, N, opq_gdim(), opq_bid());
    pg8::gemm_phase<Epi, pg8::StaticOrder, false>((PG8_LAS unsigned char*)lds, g, S, E, nullptr);
}

template <bool GATES, bool FINAL>
__device__ __forceinline__ void phase_ln(const float* __restrict__ Z, const float* __restrict__ g, const float* __restrict__ b, float* __restrict__ X, u16* __restrict__ xb, float* __restrict__ st,
                         const float* __restrict__ w_in_l, const float* __restrict__ gate_b, float* __restrict__ gates, float* ldsf) {
    const int tid = opq_tid(), wid = tid >> 6, lane = tid & 63;
    if (GATES) {
        __syncthreads();
        float gw[32];
#pragma unroll
        for (int e = 0; e < 32; ++e) { const int i = tid + NTHR * e; gw[e] = w_in_l[(size_t)(i >> 3) * PW + NPJ + (i & 7)]; }
#pragma unroll
        for (int e = 0; e < 32; ++e) { const int i = tid + NTHR * e; ldsf[(i & 7) * 2048 + (i >> 3)] = gw[e]; }
        __syncthreads();
    }
    for (int row0 = (opq_bid() * 8 + wid) * 2; row0 < T_; row0 += opq_gdim() * 16) {
        f32x4_t v[2][8];
#pragma unroll
        for (int rr = 0; rr < 2; ++rr)
#pragma unroll
            for (int i = 0; i < 8; ++i) v[rr][i] = *(const f32x4_t*)(Z + (size_t)(row0 + rr) * DM + 4 * (lane + 64 * i));
#pragma unroll
        for (int rr = 0; rr < 2; ++rr) {
            const int row = row0 + rr;
            float sm = 0.f;
#pragma unroll
            for (int i = 0; i < 8; ++i) sm += (v[rr][i][0] + v[rr][i][1]) + (v[rr][i][2] + v[rr][i][3]);
            const float mean = wave_sum(sm, lane) * (1.0f / 2048.0f);
            float qq = 0.f;
#pragma unroll
            for (int i = 0; i < 8; ++i) { const f32x4_t a = v[rr][i] - mean; qq += (a[0] * a[0] + a[1] * a[1]) + (a[2] * a[2] + a[3] * a[3]); }
            const float rstd = 1.0f / sqrtf(wave_sum(qq, lane) * (1.0f / 2048.0f) + 1e-5f);
            if (!FINAL && lane == 0) *(float2*)(st + (size_t)row * 2) = make_float2(mean, rstd);
#pragma unroll
            for (int i = 0; i < 8; ++i) {
                const int c4 = lane + 64 * i;
                const f32x4_t gv = *(const f32x4_t*)(g + 4 * c4), bv = *(const f32x4_t*)(b + 4 * c4);
                const f32x4_t y = (v[rr][i] - mean) * rstd * gv + bv;
                if (FINAL) *(f32x4_t*)(X + (size_t)row * DM + 4 * c4) = y;
                else { uint2 w; w.x = pk2(y[0], y[1]); w.y = pk2(y[2], y[3]); *(uint2*)(xb + (size_t)row * DM + 4 * c4) = w; }
                v[rr][i] = y;
            }
        }
        if (GATES) {
#pragma unroll 1
            for (int j = 0; j < 8; ++j) {
                float a0 = 0.f, a1 = 0.f;
#pragma unroll
                for (int i = 0; i < 8; ++i) { const f32x4_t wv = *(const f32x4_t*)(ldsf + j * 2048 + 4 * (lane + 64 * i)); const f32x4_t p0 = v[0][i] * wv, p1 = v[1][i] * wv; a0 += (p0[0] + p0[1]) + (p0[2] + p0[3]); a1 += (p1[0] + p1[1]) + (p1[2] + p1[3]); }
                a0 = wave_sum(a0, lane); a1 = wave_sum(a1, lane);
                if (lane == 0) { gates[(size_t)row0 * 8 + j] = a0 + gate_b[j]; gates[(size_t)(row0 + 1) * 8 + j] = a1 + gate_b[j]; }
            }
        }
    }
}

__device__ __forceinline__ void rot8c(u16* pa, u16* pb, u32x4_t a, u32x4_t b, f32x4_t c0, f32x4_t c1, f32x4_t s0, f32x4_t s1, float sc) {
    u32x4_t oa, ob;
#pragma unroll
    for (int k = 0; k < 4; ++k) {
        const float t1l = bf2f((u16)(a[k] & 0xffff)), t1h = bf2f((u16)(a[k] >> 16)), t2l = bf2f((u16)(b[k] & 0xffff)), t2h = bf2f((u16)(b[k] >> 16));
        const float cl = k < 2 ? c0[2 * k] : c1[2 * k - 4], ch = k < 2 ? c0[2 * k + 1] : c1[2 * k - 3], sl = k < 2 ? s0[2 * k] : s1[2 * k - 4], sh = k < 2 ? s0[2 * k + 1] : s1[2 * k - 3];
        oa[k] = pk2((t1l * cl - t2l * sl) * sc, (t1h * ch - t2h * sh) * sc);
        ob[k] = pk2((t1l * sl + t2l * cl) * sc, (t1h * sh + t2h * ch) * sc);
    }
    *(u32x4_t*)pa = oa; *(u32x4_t*)pb = ob;
}
template <int NI_SHIFT, int DP, int TW>
__device__ __forceinline__ void rot_sweep(u16* proj, const float* ctab, const float* stab, int mode) {
    const int gtid = opq_bid() * NTHR + opq_tid(), gn = opq_gdim() * NTHR;
    const float KS = 0.08838834764831845f;
    for (int i0 = gtid; i0 < (T_ << NI_SHIFT); i0 += 4 * gn) {
        u16* pp[4]; u32x4_t a[4], b[4]; f32x4_t c0[4], c1[4], s0[4], s1[4]; float sc[4]; bool ok[4];
#pragma unroll
        for (int e = 0; e < 4; ++e) {
            const int i = i0 + e * gn; ok[e] = i < (T_ << NI_SHIFT);
            const int t = ok[e] ? i >> NI_SHIFT : 0, r = i & ((1 << NI_SHIFT) - 1), s = t & 4095;
            int blk, j0;
            if (mode == 0) { const int qk = r >> 5, h = (r >> 3) & 3; j0 = (r & 7) * 8; blk = qk * 4 + h; sc[e] = qk ? KS : 1.0f; }
            else { const int grp = r >> 1; j0 = (r & 1) * 8; blk = 16 + grp; sc[e] = 1.0f; }
            pp[e] = proj + (size_t)blk * PBLK + (size_t)t * 128 + j0;
            a[e] = *(const u32x4_t*)pp[e]; b[e] = *(const u32x4_t*)(pp[e] + DP);
            const float* ct = ctab + s * TW + j0; const float* st = stab + s * TW + j0;
            c0[e] = *(const f32x4_t*)ct; c1[e] = *(const f32x4_t*)(ct + 4); s0[e] = *(const f32x4_t*)st; s1[e] = *(const f32x4_t*)(st + 4);
        }
#pragma unroll
        for (int e = 0; e < 4; ++e) if (ok[e]) rot8c(pp[e], pp[e] + DP, a[e], b[e], c0[e], c1[e], s0[e], s1[e], sc[e]);
    }
}
__device__ __forceinline__ void phase_prep(const Params& p, int l) {
    const int gtid = opq_bid() * NTHR + opq_tid(), gn = opq_gdim() * NTHR;
    u16* proj = (u16*)(p.ws + OFF_HP); u16* mqk = (u16*)(p.ws + OFF_MQK);
    const float* retc = (const float*)(p.ws + OFF_TAB); const float* rets = retc + 4096 * 64; const float* difc = rets + 4096 * 64; const float* difs = difc + 4096 * 16;
    const float KS = 0.08838834764831845f;
    const float* cw = p.in[9] + (size_t)l * 4 * 1024; const float* cb = p.in[10] + (size_t)l * 1024;
    const int c0 = (gtid & 127) * 8;
    f32x4_t w[4][2], bb[2];
#pragma unroll
    for (int j = 0; j < 4; ++j) { w[j][0] = *(const f32x4_t*)(cw + j * 1024 + c0); w[j][1] = *(const f32x4_t*)(cw + j * 1024 + c0 + 4); }
    bb[0] = *(const f32x4_t*)(cb + c0); bb[1] = *(const f32x4_t*)(cb + c0 + 4);
    const u16* src = proj + (size_t)(40 + (c0 >> 7)) * PBLK + (c0 & 127);
    u16* dst = mqk + (size_t)(c0 >> 7) * PBLK + (c0 & 127);
    const float sck = c0 >= 512 ? KS : 1.0f;
    for (int i0 = gtid; i0 < T_ * 128; i0 += 4 * gn) {
        u32x4_t x[4][4];
#pragma unroll
        for (int e = 0; e < 4; ++e) {
            const int i = i0 + e * gn, t = i < T_ * 128 ? i >> 7 : 0, s = t & 4095;
#pragma unroll
            for (int j = 0; j < 4; ++j) x[e][j] = (s - 3 + j >= 0) ? *(const u32x4_t*)(src + (size_t)(t - 3 + j) * 128) : (u32x4_t){0u, 0u, 0u, 0u};
        }
#pragma unroll
        for (int e = 0; e < 4; ++e) {
            const int i = i0 + e * gn;
            if (i < T_ * 128) {
                const int t = i >> 7;
                f32x4_t y0 = bb[0], y1 = bb[1];
#pragma unroll
                for (int j = 0; j < 4; ++j) {
                    const u32x4_t xv = x[e][j];
                    const f32x4_t lo = {bf2f((u16)(xv[0] & 0xffff)), bf2f((u16)(xv[0] >> 16)), bf2f((u16)(xv[1] & 0xffff)), bf2f((u16)(xv[1] >> 16))};
                    const f32x4_t hi = {bf2f((u16)(xv[2] & 0xffff)), bf2f((u16)(xv[2] >> 16)), bf2f((u16)(xv[3] & 0xffff)), bf2f((u16)(xv[3] >> 16))};
                    y0 += w[j][0] * lo; y1 += w[j][1] * hi;
                }
                u32x4_t o;
                o[0] = pk2(silu_f(y0[0]) * sck, silu_f(y0[1]) * sck); o[1] = pk2(silu_f(y0[2]) * sck, silu_f(y0[3]) * sck);
                o[2] = pk2(silu_f(y1[0]) * sck, silu_f(y1[1]) * sck); o[3] = pk2(silu_f(y1[2]) * sck, silu_f(y1[3]) * sck);
                *(u32x4_t*)(dst + (size_t)t * 128) = o;
            }
        }
    }
}

__device__ __forceinline__ da::BlockRef<__hip_bfloat16, float> diff_ref(int inst, int qb, const __hip_bfloat16* proj, float* Od) {
    const int b = inst >> 4, h = (inst >> 2) & 3, m = (inst >> 1) & 1, e = inst & 1;
    da::BlockRef<__hip_bfloat16, float> r;
    r.Q = proj + (size_t)(16 + 2 * h + m) * PBLK + (size_t)(b * 4096 + qb * 256) * 128;
    r.K = proj + (size_t)(24 + 2 * h + m) * PBLK + (size_t)(b * 4096) * 128;
    r.V = proj + (size_t)(32 + 2 * h + e) * PBLK + (size_t)(b * 4096) * 128;
    r.O = Od + (size_t)(b * 4096 + qb * 256) * DM + h * 512 + m * 256 + e * 128;
    r.P0 = qb * 256;
    return r;
}
__device__ __forceinline__ void phase_diffattn(const Params& p, unsigned char* lds) {
    typedef __hip_bfloat16 TI;
    const TI* proj = (const TI*)(p.ws + OFF_HP); float* Od = p.out;
    const int total = 512, stride = opq_gdim();
    const int Wrt = 4096 + (p.ws == nullptr ? 64 : 0), SKVrt = 4096 + (p.out == nullptr ? 64 : 0);
#define IT_INST(L_) ((((L_) & 7) << 3) + ((L_) >> 6))
#define IT_X(L_) (((L_) >> 3) & 7)
    int L = opq_bid(); if (L >= total) return;
    int pass = 0;
    da::BlockRef<TI, float> cur = diff_ref(IT_INST(L), IT_X(L), proj, Od);
    da::Seam<TI> S;
    da::causal_swa_prime<TI, float>(cur, Wrt, (char*)lds, S);
    for (;;) {
        const bool more_pass = pass == 0, more_item = L + stride < total, last = !more_pass && !more_item;
        int passn = pass + 1, Ln = L;
        if (!more_pass) { passn = 0; Ln = more_item ? L + stride : L; }
        const int qbn = passn ? 15 - IT_X(Ln) : IT_X(Ln);
        const da::BlockRef<TI, float> nxt = last ? cur : diff_ref(IT_INST(Ln), qbn, proj, Od);
        da::causal_swa_block<TI, float>(cur, nxt, SKVrt, Wrt, (char*)lds, S);
        if (last) break;
        cur = nxt; pass = passn; L = Ln;
    }
}
__device__ __forceinline__ void phase_diffcomb(const Params& p, int l) {
    const int tid = opq_tid(), wid = tid >> 6, lane = tid & 63;
    const float* Od = p.out; u16* mixed = (u16*)(p.ws + OFF_MIX);
    const float* dl = p.in[7] + (size_t)l * 512; const float* g = p.in[8] + (size_t)l * 256;
    const float lam_init = 0.8f - 0.6f * __expf(-0.3f * (float)l);
    const float s1 = wave_sum(dl[lane] * dl[128 + lane] + dl[64 + lane] * dl[192 + lane], lane);
    const float s2 = wave_sum(dl[256 + lane] * dl[384 + lane] + dl[320 + lane] * dl[448 + lane], lane);
    const float lam = __expf(s1) - __expf(s2) + lam_init;
    const float4 gv = ((const float4*)g)[lane];
    const float post = 1.0f - lam_init;
    for (int u0 = (opq_bid() * 8 + wid) * 4; u0 < T_ * 4; u0 += opq_gdim() * 32) {
        float4 a0[4], a1[4];
#pragma unroll
        for (int k = 0; k < 4; ++k) { const float4* o0 = (const float4*)(Od + (size_t)(u0 >> 2) * DM + k * 512); a0[k] = o0[lane]; a1[k] = o0[64 + lane]; }
#pragma unroll
        for (int k = 0; k < 4; ++k) {
            float4 v; v.x = a0[k].x - lam * a1[k].x; v.y = a0[k].y - lam * a1[k].y; v.z = a0[k].z - lam * a1[k].z; v.w = a0[k].w - lam * a1[k].w;
            const float ss = wave_sum((v.x * v.x + v.y * v.y) + (v.z * v.z + v.w * v.w), lane);
            const float rms = 1.0f / sqrtf(ss * (1.0f / 256.0f) + 1e-6f) * post;
            uint2 w; w.x = pk2(v.x * rms * gv.x, v.y * rms * gv.y); w.y = pk2(v.z * rms * gv.z, v.w * rms * gv.w);
            *(uint2*)(mixed + (size_t)(u0 >> 2) * DM + 512 + k * 256 + 4 * lane) = w;
        }
    }
}

__device__ __forceinline__ bf16x8_t frag(const u16* tile, int row0, int k0, int lane) {
    return *(const bf16x8_t*)(tile + (row0 + (lane & 15)) * LDT + k0 + 8 * (lane >> 4));
}
#define TILE_LOAD(rg, TR, src, ld) do { _Pragma("unroll") for (int k_ = 0; k_ < L / 32; ++k_) { const int i_ = tid + NTHR * k_; \
        const int r_ = (TR) ? (((i_ % L) + rot) & (L - 1)) : (((i_ >> 4) + rot) & (L - 1)), c_ = (TR) ? (i_ / L) * 8 : (i_ & 15) * 8; \
        rg[k_] = *(const u32x4_t*)((src) + (size_t)r_ * (ld) + c_); } } while (0)
#define TILE_STORE_ROWS(dst, rg) do { _Pragma("unroll") for (int k_ = 0; k_ < L / 32; ++k_) { const int i_ = tid + NTHR * k_, r_ = ((i_ >> 4) + rot) & (L - 1), c_ = (i_ & 15) * 8; \
        *(u32x4_t*)((dst) + r_ * LDT + c_) = rg[k_]; } } while (0)
__device__ __forceinline__ void store_T8(u16* dst, int c8, int r, u32x4_t v, const float* rowscale) {
    const float sc = rowscale ? rowscale[r] : 1.0f;
#pragma unroll
    for (int q = 0; q < 4; ++q) {
        u16 lo = (u16)(v[q] & 0xffff), hi = (u16)(v[q] >> 16);
        if (rowscale) { lo = f2bf(bf2f(lo) * sc); hi = f2bf(bf2f(hi) * sc); }
        dst[(c8 + 2 * q) * LDT + r] = lo; dst[(c8 + 2 * q + 1) * LDT + r] = hi;
    }
}
#define TILE_STORE_T(dst, rg, rowscale) do { _Pragma("unroll") for (int k_ = 0; k_ < L / 32; ++k_) { const int i_ = tid + NTHR * k_, r_ = ((i_ % L) + rot) & (L - 1), c_ = (i_ / L) * 8; \
        store_T8((dst), c_, r_, rg[k_], (rowscale)); } } while (0)
template <int TYPE>
__device__ __forceinline__ void chunk_l1(const Params& p, unsigned char* lds) {
    constexpr int L = TYPE ? 64 : 128, NC = 4096 / L, NIT = 16 * NC;
    const int tid = opq_tid(), wid = tid >> 6, lane = tid & 63;
    u16* sK = (u16*)lds; u16* sV = sK + 128 * LDT; float* sW = (float*)(lds + 2 * 128 * LDT * 2);
    const u16* proj = (const u16*)(p.ws + OFF_HP); const u16* mqk = (const u16*)(p.ws + OFF_MQK); const float* gates = (const float*)(p.ws + OFF_GATE);
    float* ST = (float*)(p.ws + (TYPE ? OFF_STM : OFF_STR)); float* nm = (float*)(p.ws + OFF_NM); float* scb = (float*)(p.ws + OFF_SC);
    for (int it = opq_bid(); it < NIT; it += opq_gdim()) {
        const int bh = it / NC, c = it % NC, b = bh >> 2, h = bh & 3; const size_t t0 = (size_t)b * 4096 + (size_t)c * L;
        const int rot = (opq_bid() * 29) & (L - 1);
        u32x4_t rk[L / 32], rv[L / 32];
        if (TYPE == 0) { TILE_LOAD(rk, true, proj + (size_t)(4 + h) * PBLK + t0 * 128, 128); TILE_LOAD(rv, true, proj + (size_t)(8 + h) * PBLK + t0 * 128, 128); }
        else           { TILE_LOAD(rk, true, mqk + (size_t)(4 + h) * PBLK + t0 * 128, 128); TILE_LOAD(rv, true, proj + (size_t)(48 + h) * PBLK + t0 * 128, 128); }
        float fp = 0.f, ip = 0.f;
        if (TYPE == 1 && wid == 0) { fp = gates[(t0 + lane) * 8 + 4 + h]; ip = gates[(t0 + lane) * 8 + h]; }
        __syncthreads();
        if (TYPE == 0) { if (tid < 128) { const float lg = ret_logg(h); sW[tid] = __expf((float)(127 - tid) * lg); } }
        else if (wid == 0) {
            const float bb = scan_sum(logsig_f(fp), lane), bL = __int_as_float(__builtin_amdgcn_readlane(__float_as_int(bb), 63)), wl = bL - bb + ip, wmax = wave_max(wl, lane);
            sW[lane] = __expf(wl - wmax);
            if (lane == 0) { scb[(bh * 64 + c) * 4 + 0] = bL; scb[(bh * 64 + c) * 4 + 1] = wmax; }
        }
        __syncthreads();
        TILE_STORE_T(sK, rk, sW); TILE_STORE_T(sV, rv, (const float*)nullptr);
        __syncthreads();
        f32x4_t acc[8];
#pragma unroll
        for (int ct = 0; ct < 8; ++ct) acc[ct] = (f32x4_t){0.f, 0.f, 0.f, 0.f};
        for (int j0 = 0; j0 < L; j0 += 32) {
            const bf16x8_t a = frag(sK, 16 * wid, j0, lane);
#pragma unroll
            for (int ct = 0; ct < 8; ++ct) { const bf16x8_t bb = frag(sV, 16 * ct, j0, lane); acc[ct] = __builtin_amdgcn_mfma_f32_16x16x32_bf16(a, bb, acc[ct], 0, 0, 0); }
        }
        float* dst = ST + (size_t)(bh * NC + c) * 16384;
#pragma unroll
        for (int ct = 0; ct < 8; ++ct)
#pragma unroll
            for (int r = 0; r < 4; ++r) dst[(16 * wid + 4 * (lane >> 4) + r) * 128 + 16 * ct + (lane & 15)] = acc[ct][r];
        if (TYPE == 1 && tid < 128) { float s = 0.f; for (int j = 0; j < L; ++j) s += bf2f(sK[tid * LDT + j]); nm[(size_t)(bh * 64 + c) * 128 + tid] = s; }
    }
}
__device__ __forceinline__ void chunk_scan(const Params& p) {
    const int gtid = opq_bid() * NTHR + opq_tid(), gn = opq_gdim() * NTHR;
    float* str = (float*)(p.ws + OFF_STR); float* stm = (float*)(p.ws + OFF_STM); float* nm = (float*)(p.ws + OFF_NM); float* scb = (float*)(p.ws + OFF_SC);
    for (int u = gtid; u < 2 * 65536 + 2048; u += gn) {
        if (u < 65536) {
            const int bh = u >> 12, e4 = u & 4095, h = bh & 3;
            const float lg = ret_logg(h), dec = __expf(128.0f * lg);
            float4* ptr = (float4*)(str + (size_t)bh * 32 * 16384) + e4; float4 C = make_float4(0.f, 0.f, 0.f, 0.f);
#pragma unroll 16
            for (int c = 0; c < 32; ++c) { const float4 kv = ptr[(size_t)c * 4096]; ptr[(size_t)c * 4096] = C; C.x = dec * C.x + kv.x; C.y = dec * C.y + kv.y; C.z = dec * C.z + kv.z; C.w = dec * C.w + kv.w; }
        } else if (u < 2 * 65536) {
            const int v = u - 65536, bh = v >> 12, e4 = v & 4095;
            float4* ptr = (float4*)(stm + (size_t)bh * 64 * 16384) + e4; const float* sp = scb + bh * 64 * 4; float4 C = make_float4(0.f, 0.f, 0.f, 0.f); float m = 0.f;
#pragma unroll 16
            for (int c = 0; c < 64; ++c) {
                const float bL = sp[c * 4], wmax = sp[c * 4 + 1], mn = fmaxf(bL + m, wmax), dec = __expf(bL + m - mn), sc = __expf(wmax - mn);
                const float4 kv = ptr[(size_t)c * 4096]; ptr[(size_t)c * 4096] = C;
                C.x = dec * C.x + sc * kv.x; C.y = dec * C.y + sc * kv.y; C.z = dec * C.z + sc * kv.z; C.w = dec * C.w + sc * kv.w; m = mn; }
        } else {
            const int v = u - 2 * 65536, bh = v >> 7, e = v & 127;
            float* ptr = nm + (size_t)bh * 64 * 128 + e; float* sp = scb + bh * 64 * 4; float C = 0.f, m = 0.f;
#pragma unroll 8
            for (int c = 0; c < 64; ++c) {
                const float bL = sp[c * 4], wmax = sp[c * 4 + 1], mn = fmaxf(bL + m, wmax), dec = __expf(bL + m - mn), sc = __expf(wmax - mn);
                const float kv = ptr[c * 128]; ptr[c * 128] = C; if (e == 0) sp[c * 4 + 2] = m; C = dec * C + sc * kv; m = mn; }
        }
    }
}
template <int TYPE>
__device__ __forceinline__ void chunk_l3(const Params& p, int l, unsigned char* lds) {
    constexpr int L = TYPE ? 64 : 128, NC = 4096 / L, NIT = 16 * NC, NRT = L / 16, WPR = 8 / NRT, NCT = 8 / WPR;
    const int tid = opq_tid(), wid = tid >> 6, lane = tid & 63;
    u16* sQ = (u16*)lds; u16* sK = sQ + 128 * LDT; u16* sV = sK + 128 * LDT; u16* sC = sV + 128 * LDT;
    float* sF = (float*)(lds + 4 * 128 * LDT * 2);
    float* rowoff = sF, * uvec = sF + 128, * inter = sF + 256, * emt = sF + 384, * den = sF + 512, * qn = sF + 640, * nst = sF + 768;
    float* sH = (float*)lds;
    const u16* proj = (const u16*)(p.ws + OFF_HP); const u16* mqk = (const u16*)(p.ws + OFF_MQK); const float* gates = (const float*)(p.ws + OFF_GATE);
    const float* ST = (const float*)(p.ws + (TYPE ? OFF_STM : OFF_STR)); const float* nm = (const float*)(p.ws + OFF_NM); const float* scb = (const float*)(p.ws + OFF_SC);
    u16* mixed = (u16*)(p.ws + OFF_MIX);
    const float* ng = TYPE ? (p.in[12] + (size_t)l * 512) : (p.in[6] + (size_t)l * 512);
    for (int it = opq_bid(); it < NIT; it += opq_gdim()) {
        const int bh = it / NC, c = it % NC, b = bh >> 2, h = bh & 3; const size_t t0 = (size_t)b * 4096 + (size_t)c * L;
        const int rot = (opq_bid() * 29) & (L - 1);
        u32x4_t rq[L / 32], rk[L / 32], rv[L / 32]; f32x4_t rc[8];
        if (TYPE == 0) { TILE_LOAD(rq, false, proj + (size_t)h * PBLK + t0 * 128, 128); TILE_LOAD(rk, false, proj + (size_t)(4 + h) * PBLK + t0 * 128, 128); TILE_LOAD(rv, true, proj + (size_t)(8 + h) * PBLK + t0 * 128, 128); }
        else           { TILE_LOAD(rq, false, mqk + (size_t)h * PBLK + t0 * 128, 128); TILE_LOAD(rk, false, mqk + (size_t)(4 + h) * PBLK + t0 * 128, 128); TILE_LOAD(rv, true, proj + (size_t)(48 + h) * PBLK + t0 * 128, 128); }
        {
            const float4* Cg = (const float4*)(ST + (size_t)(bh * NC + c) * 16384);
#pragma unroll
            for (int k = 0; k < 8; ++k) { const int i = tid + NTHR * k, d = ((i & 127) + 3 * rot) & 127, v0 = (((i >> 7) + rot) & 31) * 4; rc[k] = *(const f32x4_t*)(Cg + d * 32 + (v0 >> 2)); }
        }
        float fp = 0.f, ip = 0.f, m_in = 0.f, nld = 0.f;
        if (TYPE == 1) {
            if (wid == 0) { fp = gates[(t0 + lane) * 8 + 4 + h]; ip = gates[(t0 + lane) * 8 + h]; m_in = scb[(bh * 64 + c) * 4 + 2]; }
            if (tid >= 128 && tid < 256) nld = nm[(size_t)(bh * 64 + c) * 128 + tid - 128];
        }
        __syncthreads();
        TILE_STORE_ROWS(sQ, rq); TILE_STORE_ROWS(sK, rk); TILE_STORE_T(sV, rv, (const float*)nullptr);
#pragma unroll
        for (int k = 0; k < 8; ++k) { const int i = tid + NTHR * k, d = ((i & 127) + 3 * rot) & 127, v0 = (((i >> 7) + rot) & 31) * 4;
            sC[(v0 + 0) * LDT + d] = f2bf(rc[k][0]); sC[(v0 + 1) * LDT + d] = f2bf(rc[k][1]); sC[(v0 + 2) * LDT + d] = f2bf(rc[k][2]); sC[(v0 + 3) * LDT + d] = f2bf(rc[k][3]); }
        if (TYPE == 0) {
            if (tid < 128) { const float lg = ret_logg(h), bi = (float)(tid + 1) * lg; rowoff[tid] = bi; uvec[tid] = -bi; inter[tid] = __expf(bi); emt[tid] = 1.0f; }
        } else {
            if (wid == 0) {
                const float bb = scan_sum(logsig_f(fp), lane), uu = ip - bb, pm = scan_max(uu, lane);
                const float mt = bb + fmaxf(m_in, pm);
                rowoff[lane] = bb - mt; uvec[lane] = uu; inter[lane] = __expf(bb + m_in - mt); emt[lane] = __expf(-mt);
            }
            if (tid >= 128 && tid < 256) nst[tid - 128] = nld;
        }
        __syncthreads();
        unsigned gpre[L / 8];
#pragma unroll
        for (int k = 0; k < L / 8; ++k) gpre[k] = *(const unsigned*)(proj + (size_t)((TYPE ? 52 : 12) + h) * PBLK + (t0 + wid + 8 * k) * 128 + 2 * lane);
        f32x4_t sacc[NRT];
        if (wid < NRT) {
#pragma unroll
            for (int ct = 0; ct < NRT; ++ct) sacc[ct] = (f32x4_t){0.f, 0.f, 0.f, 0.f};
            for (int d0 = 0; d0 < 128; d0 += 32) {
                const bf16x8_t a = frag(sQ, 16 * wid, d0, lane);
#pragma unroll
                for (int ct = 0; ct < NRT; ++ct) { const bf16x8_t bb = frag(sK, 16 * ct, d0, lane); sacc[ct] = __builtin_amdgcn_mfma_f32_16x16x32_bf16(a, bb, sacc[ct], 0, 0, 0); }
            }
        }
        if (TYPE == 1) {
            for (int i = wid; i < L; i += 8) { float s = bf2f(sQ[i * LDT + lane]) * nst[lane] + bf2f(sQ[i * LDT + 64 + lane]) * nst[64 + lane]; s = wave_sum(s, lane); if (lane == 0) qn[i] = s; }
        }
        __syncthreads();
        u16* sP = sK;
        if (wid < NRT) {
#pragma unroll
            for (int r = 0; r < 4; ++r) {
                const int i = 16 * wid + 4 * (lane >> 4) + r; const float ro = rowoff[i]; float rs = 0.f;
#pragma unroll
                for (int ct = 0; ct < NRT; ++ct) { const int j = 16 * ct + (lane & 15); const float pv = (j <= i) ? sacc[ct][r] * __expf(ro + uvec[j]) : 0.f; rs += pv; sP[i * LDT + j] = f2bf(pv); }
                rs += shx(rs, 1, lane); rs += shx(rs, 2, lane); rs += shx(rs, 4, lane); rs += shx(rs, 8, lane);
                if ((lane & 15) == 0) den[i] = rs;
            }
        }
        __syncthreads();
        const int rt = wid % NRT, ctb = (wid / NRT) * NCT;
        f32x4_t acc[NCT];
#pragma unroll
        for (int ct = 0; ct < NCT; ++ct) acc[ct] = (f32x4_t){0.f, 0.f, 0.f, 0.f};
        for (int d0 = 0; d0 < 128; d0 += 32) {
            const bf16x8_t a = frag(sQ, 16 * rt, d0, lane);
#pragma unroll
            for (int ct = 0; ct < NCT; ++ct) { const bf16x8_t bb = frag(sC, 16 * (ctb + ct), d0, lane); acc[ct] = __builtin_amdgcn_mfma_f32_16x16x32_bf16(a, bb, acc[ct], 0, 0, 0); }
        }
#pragma unroll
        for (int r = 0; r < 4; ++r) { const float sc = inter[16 * rt + 4 * (lane >> 4) + r];
#pragma unroll
            for (int ct = 0; ct < NCT; ++ct) acc[ct][r] *= sc; }
        for (int j0 = 0; j0 < L; j0 += 32) {
            const bf16x8_t a = frag(sP, 16 * rt, j0, lane);
#pragma unroll
            for (int ct = 0; ct < NCT; ++ct) { const bf16x8_t bb = frag(sV, 16 * (ctb + ct), j0, lane); acc[ct] = __builtin_amdgcn_mfma_f32_16x16x32_bf16(a, bb, acc[ct], 0, 0, 0); }
        }
        __syncthreads();
#pragma unroll
        for (int ct = 0; ct < NCT; ++ct)
#pragma unroll
            for (int r = 0; r < 4; ++r) sH[(16 * rt + 4 * (lane >> 4) + r) * 129 + 16 * (ctb + ct) + (lane & 15)] = acc[ct][r];
        __syncthreads();
        const float g0 = ng[h * 128 + 2 * lane], g1 = ng[h * 128 + 2 * lane + 1];
#pragma unroll
        for (int k = 0; k < L / 8; ++k) {
            const int i = wid + 8 * k; const size_t t = t0 + i;
            float h0 = sH[i * 129 + 2 * lane], h1 = sH[i * 129 + 2 * lane + 1];
            const float ga = bf2f((u16)(gpre[k] & 0xffff)), gb = bf2f((u16)(gpre[k] >> 16));
            if (TYPE == 1) {
                const float dn = den[i] + inter[i] * qn[i], dd = fmaxf(fabsf(dn), emt[i]);
                h0 = h0 / dd * sigmoid_f(ga); h1 = h1 / dd * sigmoid_f(gb);
            }
            const float mean = wave_sum(h0 + h1, lane) * (1.0f / 128.0f), d0 = h0 - mean, d1 = h1 - mean;
            const float var = wave_sum(d0 * d0 + d1 * d1, lane) * (1.0f / 128.0f), rstd = 1.0f / sqrtf(var + 1e-6f);
            float y0 = d0 * rstd * g0, y1 = d1 * rstd * g1;
            int col;
            if (TYPE == 0) { y0 *= silu_f(ga); y1 *= silu_f(gb); col = h * 128 + 2 * lane; } else col = 1536 + h * 128 + 2 * lane;
            *(unsigned*)(mixed + t * DM + col) = pk2(y0, y1);
        }
    }
}

__device__ __forceinline__ Params load_params() {
    Params r{};
#if defined(__HIP_DEVICE_COMPILE__)
    const __attribute__((address_space(4))) Params* k = (const __attribute__((address_space(4))) Params*)__builtin_amdgcn_kernarg_segment_ptr();
    asm volatile("" : "+s"(k));
#pragma unroll
    for (int i = 0; i < 16; ++i) r.in[i] = k->in[i];
    r.out = k->out; r.ws = k->ws;
#endif
    return r;
}
#define PWS(off) (q.ws + (off))
#define GSYNC() do { const Params q_ = load_params(); XcdBarrier b_; b_.bar = (unsigned*)(q_.ws + OFF_BAR); b_.x = xb_xcc_id(); b_.st = (volatile LAS unsigned*)((LAS unsigned char*)lds + LDS_PHASE); xcd_barrier(b_); } while (0)
#ifndef PHMASK
#define PHMASK 0xFFFF
#endif
__global__ void __launch_bounds__(NTHR, 2) fwd_megakernel(Params p_unused) {
    extern __shared__ __attribute__((aligned(16))) unsigned char lds[];
    cg::grid_group grid = cg::this_grid();
    volatile LAS unsigned* xst = (volatile LAS unsigned*)((LAS unsigned char*)lds + LDS_PHASE);
    if (opq_tid() == 0) { xst[0] = 0u; xst[1] = 0u; }
    __syncthreads();
    { const Params q = load_params(); (void)xcd_barrier_post((unsigned*)PWS(OFF_BAR), xst); }
    const float ALPHA = 1.41421356237309515f;
    { const Params q = load_params(); phase_init(q); }
    grid.sync();
#define STAT(i) ((float*)PWS(OFF_STAT) + (size_t)(i) * T_ * 2)
#define LNG(i) (q.in[1] + (size_t)(i) * DM)
#define LNB(i) (q.in[2] + (size_t)(i) * DM)
#define CSL(off) ((const float*)PWS(OFF_CS) + (size_t)l * CS_LAYER + (off))
#pragma unroll 1
    for (int l = 0; l < 2; ++l) {
        { const Params q = load_params(); phase_weights(q, l, lds); }
        GSYNC();
        { const Params q = load_params(); EpiSwiGLU e; e.H = (u16*)PWS(OFF_HP); run_gemm(lds, (const u16*)PWS(OFF_XB), (const u16*)PWS(OFF_WGU1), T_, NGU, DM, e); }
        GSYNC();
        { const Params q = load_params(); EpiResid e; e.Zp = l ? (const float*)PWS(OFF_Z) : q.in[0]; e.pst = l ? STAT(2) : nullptr; e.pg = LNG(2); e.pb = LNB(2);
          e.Z = (float*)PWS(OFF_Z); e.alpha = opq_f(ALPHA); e.s = opq_f(0.5f); run_gemm(lds, (const u16*)PWS(OFF_HP), (const u16*)PWS(OFF_WD1), T_, DM, DFF, e); }
        GSYNC();
        { const Params q = load_params(); phase_ln<true, false>((const float*)PWS(OFF_Z), LNG(l * 3 + 0), LNB(l * 3 + 0), nullptr, (u16*)PWS(OFF_XB), STAT(l * 3 + 0), q.in[5] + (size_t)l * DM * PW, q.in[11] + (size_t)l * 8, (float*)PWS(OFF_GATE), (float*)lds); }
        GSYNC();
        { const Params q = load_params(); EpiProjBM e; e.O = (u16*)PWS(OFF_HP); e.tab = (const float*)PWS(OFF_TAB); run_gemm(lds, (const u16*)PWS(OFF_XB), (const u16*)PWS(OFF_WIN), T_, NPJ, DM, e); }
        GSYNC();
        { const Params q = load_params(); phase_prep(q, l); }
        GSYNC();
        { const Params q = load_params(); phase_diffattn(q, lds); }
        { const Params q = load_params(); chunk_l1<0>(q, lds); }
        { const Params q = load_params(); chunk_l1<1>(q, lds); }
        GSYNC();
        { const Params q = load_params(); chunk_scan(q); }
        GSYNC();
        { const Params q = load_params(); chunk_l3<0>(q, l, lds); }
        { const Params q = load_params(); chunk_l3<1>(q, l, lds); }
        { const Params q = load_params(); phase_diffcomb(q, l); }
        GSYNC();
        { const Params q = load_params(); EpiResid e; e.Zp = (const float*)PWS(OFF_Z); e.pst = STAT(l * 3 + 0); e.pg = LNG(l * 3 + 0); e.pb = LNB(l * 3 + 0);
          e.Z = (float*)PWS(OFF_Z); e.alpha = opq_f(ALPHA); e.s = opq_f(1.0f); run_gemm(lds, (const u16*)PWS(OFF_MIX), (const u16*)PWS(OFF_WOUT), T_, DM, DM, e); }
        GSYNC();
        { const Params q = load_params(); phase_ln<false, false>((const float*)PWS(OFF_Z), LNG(l * 3 + 1), LNB(l * 3 + 1), nullptr, (u16*)PWS(OFF_XB), STAT(l * 3 + 1), nullptr, nullptr, nullptr, (float*)lds); }
        GSYNC();
        { const Params q = load_params(); EpiSwiGLU e; e.H = (u16*)PWS(OFF_HP); run_gemm(lds, (const u16*)PWS(OFF_XB), (const u16*)PWS(OFF_WGU2), T_, NGU, DM, e); }
        GSYNC();
        { const Params q = load_params(); EpiResid e; e.Zp = (const float*)PWS(OFF_Z); e.pst = STAT(l * 3 + 1); e.pg = LNG(l * 3 + 1); e.pb = LNB(l * 3 + 1);
          e.Z = (float*)PWS(OFF_Z); e.alpha = opq_f(ALPHA); e.s = opq_f(0.5f); run_gemm(lds, (const u16*)PWS(OFF_HP), (const u16*)PWS(OFF_WD2), T_, DM, DFF, e); }
        GSYNC();
        if (l == 0) { const Params q = load_params(); phase_ln<false, false>((const float*)PWS(OFF_Z), LNG(2), LNB(2), nullptr, (u16*)PWS(OFF_XB), STAT(2), nullptr, nullptr, nullptr, (float*)lds); }
        else        { const Params q = load_params(); phase_ln<false, true>((const float*)PWS(OFF_Z), LNG(5), LNB(5), q.out, nullptr, nullptr, nullptr, nullptr, nullptr, (float*)lds); }
        if (l == 0) GSYNC();
    }
}

extern "C" void kernel_launch(void* const* d_in, const int* in_sizes, int n_in, void* d_out, int out_size, void* d_ws, size_t ws_size, hipStream_t stream) {
    static int grid_blocks = 0;
    if (grid_blocks == 0) {
        if (n_in != 16 || out_size != T_ * DM || ws_size < WS_END) { fprintf(stderr, "kernel_launch: unexpected shapes (n_in %d out %d ws %zu need %zu)\n", n_in, out_size, ws_size, (size_t)WS_END); grid_blocks = -1; return; }
        int dev = 0, cus = 0, per_cu = 0;
        (void)hipGetDevice(&dev);
        (void)hipDeviceGetAttribute(&cus, hipDeviceAttributeMultiprocessorCount, dev);
        if (hipFuncSetAttribute((const void*)fwd_megakernel, hipFuncAttributeMaxDynamicSharedMemorySize, LDS_TOTAL) != hipSuccess) fprintf(stderr, "kernel_launch: hipFuncSetAttribute failed\n");
        if (hipOccupancyMaxActiveBlocksPerMultiprocessor(&per_cu, (const void*)fwd_megakernel, NTHR, LDS_TOTAL) != hipSuccess || per_cu < 1) { fprintf(stderr, "kernel_launch: occupancy query gave %d\n", per_cu); per_cu = 1; }
        (void)hipGetLastError();
        if (cus <= 0) cus = 256;
        grid_blocks = cus * per_cu;
    }
    if (grid_blocks < 0) return;
    if (hipMemsetAsync((unsigned char*)d_ws + OFF_BAR, 0, SZ_BAR, stream) != hipSuccess) { fprintf(stderr, "kernel_launch: memset of the barrier words failed\n"); return; }
    Params p{};
    for (int i = 0; i < 16; ++i) p.in[i] = (const float*)d_in[i];
    p.out = (float*)d_out; p.ws = (unsigned char*)d_ws;
    void* args[] = {&p};
    hipError_t e = hipLaunchCooperativeKernel((const void*)fwd_megakernel, dim3(grid_blocks), dim3(NTHR), args, LDS_TOTAL, stream);
    if (e != hipSuccess) fprintf(stderr, "kernel_launch: cooperative launch failed: %s (grid %d)\n", hipGetErrorString(e), grid_blocks);
}
```

```cpp
#include <hip/hip_runtime.h>
#include <hip/hip_bf16.h>
#include <hip/hip_cooperative_groups.h>
#include <cstdio>
#include <cstdint>
namespace cg = cooperative_groups;
__device__ __forceinline__ int opq_tid() { int t = (int)threadIdx.x; asm volatile("" : "+v"(t)); return t; }
__device__ __forceinline__ int opq_bid() { int t = (int)blockIdx.x; asm volatile("" : "+s"(t)); return t; }
__device__ __forceinline__ int opq_gdim() { int t = (int)gridDim.x; asm volatile("" : "+s"(t)); return t; }
__device__ __forceinline__ float opq_f(float x) { asm volatile("" : "+v"(x)); return x; }

#define XB_TMO      128
#define XB_XCNT(j)  (256  + 64 * (j))
#define XB_XSUB(j)  (1280 + 64 * (j))
#define XB_XGEN(j)  (2304 + 64 * (j))
#define XB_TOP      3328
#define XB_TOPGEN   3392
#define XCD_BAR_WORDS 3456
#define XB_SPIN_CAP (1u << 18)
#define LAS __attribute__((address_space(3)))

__device__ __forceinline__ unsigned xb_ld(unsigned* p)              { return __hip_atomic_load(p, __ATOMIC_RELAXED, __HIP_MEMORY_SCOPE_AGENT); }
__device__ __forceinline__ unsigned xb_add(unsigned* p, unsigned v) { return __hip_atomic_fetch_add(p, v, __ATOMIC_RELAXED, __HIP_MEMORY_SCOPE_AGENT); }
__device__ __forceinline__ unsigned xb_xcc_id() { return (unsigned)__builtin_amdgcn_s_getreg((3 << 11) | 20) & 0xFu; }
#define XB_SPIN(cond, bar) do { unsigned _sp = 0; while (cond) { __builtin_amdgcn_s_sleep(1); \
    if ((++_sp & 255u) == 0u) { if (xb_ld(&(bar)[XB_TMO])) break; if (_sp > XB_SPIN_CAP) { atomicAdd(&(bar)[XB_TMO], 1u); break; } } } } while (0)

struct XcdBarrier {
    unsigned* bar; unsigned x;
    volatile LAS unsigned* st;
};

__device__ __forceinline__ XcdBarrier xcd_barrier_post(unsigned* bar, volatile LAS unsigned* st) {
    XcdBarrier b; b.bar = bar; b.x = xb_xcc_id(); b.st = st;
    if (opq_tid() == 0) (void)xb_add(&bar[XB_XCNT(b.x)], 1u);
    return b;
}
__device__ __forceinline__ void xcd_barrier_complete(unsigned* bar, unsigned x, unsigned& nloc, unsigned& nx) {
    const unsigned G = (unsigned)opq_gdim();
    unsigned sum, cnt, mine, sp = 0u;
    for (;;) {
        sum = 0u; cnt = 0u; mine = 0u;
#pragma unroll
        for (unsigned j = 0; j < 16; ++j) { const unsigned c = xb_ld(&bar[XB_XCNT(j)]); sum += c; cnt += (c > 0u) ? 1u : 0u; mine = (j == x) ? c : mine; }
        if (sum == G) break;
        __builtin_amdgcn_s_sleep(1);
        if ((++sp & 255u) == 0u) { if (xb_ld(&bar[XB_TMO])) break; if (sp > XB_SPIN_CAP) { atomicAdd(&bar[XB_TMO], 1u); break; } }
    }
    nloc = mine > 0u ? mine : 1u; nx = cnt > 0u ? cnt : 1u;
}

__device__ __forceinline__ void xcd_barrier(const XcdBarrier& b) {
    asm volatile("s_waitcnt vmcnt(0)" ::: "memory");
    __syncthreads();
    if (opq_tid() == 0) {
        unsigned* bar = b.bar;
        __builtin_amdgcn_s_waitcnt(0);
        unsigned nloc = b.st[0], nx = b.st[1];
        if (nloc == 0u) { xcd_barrier_complete(bar, b.x, nloc, nx); b.st[0] = nloc; b.st[1] = nx; }
        const unsigned old = xb_add(&bar[XB_XSUB(b.x)], 1u);
        const unsigned gen = old / nloc;
        if (old + 1u == (gen + 1u) * nloc) {
            __builtin_amdgcn_fence(__ATOMIC_RELEASE, "agent");
            asm volatile("s_waitcnt vmcnt(0)" ::: "memory");
            const unsigned og = xb_add(&bar[XB_TOP], 1u);
            const unsigned tg = og / nx;
            if (og + 1u == (tg + 1u) * nx) xb_add(&bar[XB_TOPGEN], 1u);
            else XB_SPIN(xb_ld(&bar[XB_TOPGEN]) == tg, bar);
            __builtin_amdgcn_fence(__ATOMIC_ACQUIRE, "agent");
            xb_add(&bar[XB_XGEN(b.x)], 1u);
            asm volatile("s_waitcnt vmcnt(0)" ::: "memory");
        } else {
            XB_SPIN(xb_ld(&bar[XB_XGEN(b.x)]) == gen, bar);
            __builtin_amdgcn_fence(__ATOMIC_ACQUIRE, "agent");
            asm volatile("s_waitcnt vmcnt(0)" ::: "memory");
        }
    }
    __syncthreads();
}

namespace pg8 {
#define PG8_LAS __attribute__((address_space(3)))
typedef unsigned short bf16_t;
typedef short bf16x8 __attribute__((ext_vector_type(8)));
typedef float f32x4 __attribute__((ext_vector_type(4)));
typedef unsigned u32x4 __attribute__((ext_vector_type(4)));
constexpr int BM = 256, BK = 64, HALF = 128, HTB = HALF * BK * 2  , STAGE_BYTES = 8 * HTB, NXCD = 8, WGM = 8;

__host__ __device__ __forceinline__ int lds_byte(int r, int c) { const int st = (r >> 4) * 2 + (c >> 5), rr = r & 15, cc = c & 31, ob = rr * 64 + cc * 2; return st * 1024 + (ob ^ (((ob >> 9) & 1) << 5)); }
__host__ __device__ __forceinline__ void stage_rc(int b, int& R, int& C) { const int st = b / 1024, sb = b % 1024, swz = sb ^ (((sb >> 9) & 1) << 5); R = (st >> 1) * 16 + swz / 64; C = (st & 1) * 32 + (swz % 64) / 2; }
__host__ __device__ __forceinline__ int perm32(int rho) { const int n = rho >> 4, i = rho & 15; return 8 * (i >> 2) + 4 * n + (i & 3); }

struct Unit { int pm, pn; };
struct Gemm { const bf16_t* A; const bf16_t* Bt; int M, N, K; };

struct StaticOrder {
    int nM, nN, nwg, G, c;
    __host__ __device__ void init(int M, int N, int G_, int c_) { nM = M / BM; nN = N / BM; nwg = nM * nN; G = G_; c = c_; }
    __host__ __device__ bool next(int i, Unit& u) const {
        const long L = (long)i * G + c; if (L >= nwg) return false;
        int wgid = (int)L; { const int q = nwg / NXCD, r = nwg % NXCD, xcd = wgid % NXCD, off = wgid / NXCD; wgid = (xcd < r ? xcd * (q + 1) : r * (q + 1) + (xcd - r) * q) + off; }
        const int nig = WGM * nN, gid = wgid / nig, fm = gid * WGM, gsz = (nM - fm) < WGM ? (nM - fm) : WGM;
        u.pm = fm + ((wgid % nig) % gsz); u.pn = (wgid % nig) / gsz; return true;
    }
    __device__ __forceinline__ void a_ready(const Unit&) const {}
    __device__ __forceinline__ void done(const Unit&) const {}
};
__device__ __forceinline__ unsigned cvt_pk_bf16(float lo, float hi) { unsigned r; asm volatile("v_cvt_pk_bf16_f32 %0, %1, %2" : "=v"(r) : "v"(lo), "v"(hi)); return r; }
typedef float f32x2 __attribute__((ext_vector_type(2)));
__device__ __forceinline__ f32x2 gelu_pk(f32x2 v) {
    const f32x2 av = __builtin_elementwise_abs(v), d = av * 0.2316418882f + 1.0f;
    f32x2 t; t.x = __builtin_amdgcn_rcpf(d.x); t.y = __builtin_amdgcn_rcpf(d.y);
    f32x2 q = t * 0.5307027145f + (-0.7265760135f); q = q * t + 0.7107068705f; q = q * t + (-0.142248368f); q = q * t + 0.127414796f; q = q * t;
    const f32x2 s = (v * v) * (-0.72134752044f);
    f32x2 e; e.x = __builtin_amdgcn_exp2f(s.x); e.y = __builtin_amdgcn_exp2f(s.y);
    const f32x2 m = v * (q * e), r = v - m;
    f32x2 o; o.x = v.x < 0.f ? m.x : r.x; o.y = v.y < 0.f ? m.y : r.y; return o;
}

struct EpiF32 {
    static constexpr bool PERM = false, AFTER_DRAIN = false;
    float* C; int ldc; const float* bias;
    __device__ __forceinline__ void operator()(const f32x4 (&acc)[2][2][4][2], const Unit& u, int wr, int wc, int fr, int fq) const {
        const int row0 = u.pm * BM + wr * 64 + fr, col0 = u.pn * BM + wc * 32 + 4 * fq;
        f32x4 bv[2][2];
#pragma unroll
        for (int bj = 0; bj < 2; ++bj)
#pragma unroll
            for (int n = 0; n < 2; ++n) bv[bj][n] = bias ? *(const f32x4*)(bias + col0 + bj * HALF + n * 16) : (f32x4){0.f, 0.f, 0.f, 0.f};
#pragma unroll
        for (int ai = 0; ai < 2; ++ai)
#pragma unroll
            for (int m = 0; m < 4; ++m) { float* rowp = C + (size_t)(row0 + ai * HALF + m * 16) * ldc + col0;
#pragma unroll
                for (int bj = 0; bj < 2; ++bj)
#pragma unroll
                    for (int n = 0; n < 2; ++n) *(f32x4*)(rowp + bj * HALF + n * 16) = acc[ai][bj][m][n] + bv[bj][n]; }
    }
};
template <int ACT  > struct EpiBf16 {
    static constexpr bool PERM = true, AFTER_DRAIN = false;
    bf16_t* O; int ldc; const float* bias; int split_cols; size_t split_stride;
    __device__ __forceinline__ void operator()(const f32x4 (&acc)[2][2][4][2], const Unit& u, int wr, int wc, int fr, int fq) const {
        const int row0 = u.pm * BM + wr * 64 + fr; int colt = u.pn * BM; bf16_t* base = O;
        if (split_cols) { const int t = colt / split_cols; base += (size_t)t * split_stride; colt -= t * split_cols; }
        const int col0 = colt + wc * 32 + 8 * fq, bcol0 = u.pn * BM + wc * 32 + 8 * fq;
        f32x4 bv[2][2];
#pragma unroll
        for (int bj = 0; bj < 2; ++bj)
#pragma unroll
            for (int n = 0; n < 2; ++n) bv[bj][n] = bias ? *(const f32x4*)(bias + bcol0 + bj * HALF + 4 * n) : (f32x4){0.f, 0.f, 0.f, 0.f};
#pragma unroll
        for (int ai = 0; ai < 2; ++ai)
#pragma unroll
            for (int m = 0; m < 4; ++m) { bf16_t* rowp = base + (size_t)(row0 + ai * HALF + m * 16) * ldc + col0;
#pragma unroll
                for (int bj = 0; bj < 2; ++bj) { f32x4 v0 = acc[ai][bj][m][0] + bv[bj][0], v1 = acc[ai][bj][m][1] + bv[bj][1];
                    if (ACT == 1) { f32x2 a = gelu_pk((f32x2){v0[0], v0[1]}), b = gelu_pk((f32x2){v0[2], v0[3]}), c = gelu_pk((f32x2){v1[0], v1[1]}), d = gelu_pk((f32x2){v1[2], v1[3]});
                        v0 = (f32x4){a.x, a.y, b.x, b.y}; v1 = (f32x4){c.x, c.y, d.x, d.y}; }
                    if (ACT == 2) {
#pragma unroll
                        for (int j = 0; j < 4; ++j) { v0[j] = 0.5f * v0[j] * (1.0f + erff(v0[j] * 0.70710678f)); v1[j] = 0.5f * v1[j] * (1.0f + erff(v1[j] * 0.70710678f)); } }
                    u32x4 w; w.x = cvt_pk_bf16(v0[0], v0[1]); w.y = cvt_pk_bf16(v0[2], v0[3]); w.z = cvt_pk_bf16(v1[0], v1[1]); w.w = cvt_pk_bf16(v1[2], v1[3]);
                    *(u32x4*)(rowp + bj * HALF) = w; } }
    }
};

template <class Epi, class Sched, bool STAMP = false>
__device__ __forceinline__ void gemm_phase(PG8_LAS unsigned char* lds, const Gemm g, const Sched& S, const Epi& E, unsigned long long* stamps) {
    const int tid = opq_tid(), wid = __builtin_amdgcn_readfirstlane(tid >> 6), lane = tid & 63, wr = wid >> 2, wc = wid & 3, fr = lane & 15, fq = lane >> 4;
    const int K = g.K, nt = K / BK;
    int ts_lo = 0, ts_hi = 0, nts = 0; const unsigned long long rt_entry = STAMP ? (unsigned long long)wall_clock64() : 0ull;
#define PG8_STAMP() do { if (STAMP && wid == 0 && nts < 64) { const unsigned long long _c = (unsigned long long)clock64(); \
        ts_lo = (lane == nts) ? (int)(unsigned)_c : ts_lo; ts_hi = (lane == nts) ? (int)(unsigned)(_c >> 32) : ts_hi; ++nts; } } while (0)
    PG8_STAMP();
    unsigned voffA[2], voffB[2];
#pragma unroll
    for (int i = 0; i < 2; ++i) { int R, C; stage_rc(tid * 16 + i * 8192, R, C); const int Rb = Epi::PERM ? ((R & ~31) + perm32(R & 31)) : R;
        voffA[i] = (unsigned)(R * K + C) * 2u; voffB[i] = (unsigned)(Rb * K + C) * 2u; }
    const size_t kstep = (size_t)(BK * 2);
    const size_t hstep = (size_t)HALF * K * 2;
    const size_t tstep = 2 * hstep;
    const unsigned ldsw = (unsigned)wid * 1024u;
    const int aoff = lds_byte(wr * 64 + fr, fq * 8), boff = lds_byte(wc * 32 + fr, fq * 8);
#define PG8_SA(b, h) (((b) * 2 + (h)) * HTB)
#define PG8_SB(b, h) ((4 + (b) * 2 + (h)) * HTB)
#define PG8_STAGE(bufoff, gbase, voff) do { _Pragma("unroll") for (int _i = 0; _i < 2; ++_i) \
        __builtin_amdgcn_global_load_lds((const unsigned*)((const char*)(gbase) + (voff)[_i]), (PG8_LAS unsigned*)(lds + (bufoff) + ldsw + _i * 8192), 16, 0, 0); } while (0)
#define PG8_LDA(dst, b, h) do { _Pragma("unroll") for (int m = 0; m < 4; ++m) _Pragma("unroll") for (int k = 0; k < 2; ++k) dst[m][k] = *(const PG8_LAS bf16x8*)(lds + PG8_SA(b, h) + aoff + m * 2048 + k * 1024); } while (0)
#define PG8_LDB(dst, b, h) do { _Pragma("unroll") for (int n = 0; n < 2; ++n) _Pragma("unroll") for (int k = 0; k < 2; ++k) dst[n][k] = *(const PG8_LAS bf16x8*)(lds + PG8_SB(b, h) + boff + n * 2048 + k * 1024); } while (0)
#define PG8_MMA(ai, bj, At, Bt) do { __builtin_amdgcn_s_setprio(1); _Pragma("unroll") for (int m = 0; m < 4; ++m) _Pragma("unroll") for (int n = 0; n < 2; ++n) _Pragma("unroll") for (int k = 0; k < 2; ++k) \
        acc[ai][bj][m][n] = __builtin_amdgcn_mfma_f32_16x16x32_bf16(Bt[n][k], At[m][k], acc[ai][bj][m][n], 0, 0, 0); __builtin_amdgcn_s_setprio(0); } while (0)
#define PG8_WAIT_V(n) asm volatile("s_waitcnt vmcnt(" #n ")" ::: "memory")
#define PG8_WAIT_L(n) asm volatile("s_waitcnt lgkmcnt(" #n ")" ::: "memory")
#define PG8_BAR __builtin_amdgcn_s_barrier()
#define PG8_SCHED __builtin_amdgcn_sched_barrier(0)
    Unit cur, nxt; int ui = 0;
    if (!S.next(0, cur)) return;
    f32x4 acc[2][2][4][2];
#pragma unroll
    for (int a = 0; a < 2; ++a)
#pragma unroll
        for (int b = 0; b < 2; ++b)
#pragma unroll
            for (int m = 0; m < 4; ++m)
#pragma unroll
                for (int n = 0; n < 2; ++n) acc[a][b][m][n] = (f32x4){0.f, 0.f, 0.f, 0.f};
    bf16x8 At[4][2], B0[2][2], B1[2][2];
    const char* cA = (const char*)g.A + (size_t)cur.pm * tstep; const char* cB = (const char*)g.Bt + (size_t)cur.pn * tstep;
    S.a_ready(cur);
    PG8_STAGE(PG8_SB(0, 0), cB, voffB); PG8_STAGE(PG8_SA(0, 0), cA, voffA); PG8_STAGE(PG8_SB(0, 1), cB + hstep, voffB); PG8_STAGE(PG8_SA(0, 1), cA + hstep, voffA);
    if (wr == 1) PG8_BAR;
    PG8_WAIT_V(4); PG8_BAR;
    PG8_STAGE(PG8_SB(1, 0), cB + kstep, voffB); PG8_STAGE(PG8_SA(1, 0), cA + kstep, voffA); PG8_STAGE(PG8_SB(1, 1), cB + hstep + kstep, voffB);
    PG8_WAIT_V(6); PG8_BAR;
    PG8_STAMP();
    for (;;) {
        const bool has_next = S.next(ui + 1, nxt);
        const char* nA = has_next ? (const char*)g.A + (size_t)nxt.pm * tstep : cA; const char* nB = has_next ? (const char*)g.Bt + (size_t)nxt.pn * tstep : cB;
        for (int t = 0; t < nt; t += 2) {
            const bool last = (t == nt - 2);
            const char* a1 = cA + (size_t)(t + 1) * kstep;
            const char* a2 = last ? nA : cA + (size_t)(t + 2) * kstep; const char* b2 = last ? nB : cB + (size_t)(t + 2) * kstep;
            const char* a3 = a2 + kstep; const char* b3 = b2 + kstep;
            if (last && has_next) S.a_ready(nxt);
            PG8_LDB(B0, 0, 0); PG8_SCHED; PG8_LDA(At, 0, 0); PG8_STAGE(PG8_SA(1, 1), a1 + hstep, voffA);
            PG8_WAIT_L(8); PG8_BAR; PG8_WAIT_L(0); PG8_MMA(0, 0, At, B0); PG8_BAR; PG8_SCHED;
            PG8_LDB(B1, 0, 1); PG8_STAGE(PG8_SB(0, 0), b2, voffB);
            PG8_BAR; PG8_WAIT_L(0); PG8_MMA(0, 1, At, B1); PG8_BAR;
            PG8_LDA(At, 0, 1); PG8_STAGE(PG8_SA(0, 0), a2, voffA);
            PG8_BAR; PG8_WAIT_L(0); PG8_MMA(1, 0, At, B0); PG8_BAR; PG8_SCHED;
            PG8_STAGE(PG8_SB(0, 1), b2 + hstep, voffB);
            PG8_WAIT_V(6); PG8_BAR; PG8_MMA(1, 1, At, B1); PG8_BAR;
            PG8_LDB(B0, 1, 0); PG8_SCHED; PG8_LDA(At, 1, 0); PG8_STAGE(PG8_SA(0, 1), a2 + hstep, voffA);
            PG8_WAIT_L(8); PG8_BAR; PG8_WAIT_L(0); PG8_MMA(0, 0, At, B0); PG8_BAR; PG8_SCHED;
            PG8_LDB(B1, 1, 1); PG8_STAGE(PG8_SB(1, 0), b3, voffB);
            PG8_BAR; PG8_WAIT_L(0); PG8_MMA(0, 1, At, B1); PG8_BAR;
            PG8_LDA(At, 1, 1); PG8_STAGE(PG8_SA(1, 0), a3, voffA);
            PG8_BAR; PG8_WAIT_L(0); PG8_MMA(1, 0, At, B0); PG8_BAR; PG8_SCHED;
            PG8_STAGE(PG8_SB(1, 1), b3 + hstep, voffB);
            PG8_WAIT_V(6); PG8_BAR; PG8_MMA(1, 1, At, B1); PG8_BAR;
        }
        PG8_STAMP();
        if constexpr (!Epi::AFTER_DRAIN) { E(acc, cur, wr, wc, fr, fq); S.done(cur); }
        PG8_STAMP();
        if (!has_next) break;
#pragma unroll
        for (int a = 0; a < 2; ++a)
#pragma unroll
            for (int b = 0; b < 2; ++b)
#pragma unroll
                for (int m = 0; m < 4; ++m)
#pragma unroll
                    for (int n = 0; n < 2; ++n) acc[a][b][m][n] = (f32x4){0.f, 0.f, 0.f, 0.f};
        cur = nxt; cA = nA; cB = nB; ++ui;
    }
    PG8_WAIT_V(0);
    if (wr == 0) PG8_BAR;
    PG8_BAR;
    if constexpr (Epi::AFTER_DRAIN) { E.fused(acc, cur, wr, wc, fr, fq, lds, wid, lane); S.done(cur); }
    PG8_STAMP();
    if (STAMP && wid == 0) { stamps[lane] = lane < nts ? (((unsigned long long)(unsigned)ts_hi << 32) | (unsigned)ts_lo) : 0ull;
        if (lane == 62) stamps[62] = rt_entry; if (lane == 63) stamps[63] = (unsigned long long)wall_clock64(); }
#undef PG8_STAMP
#undef PG8_SA
#undef PG8_SB
#undef PG8_STAGE
#undef PG8_LDA
#undef PG8_LDB
#undef PG8_MMA
#undef PG8_WAIT_V
#undef PG8_WAIT_L
#undef PG8_BAR
#undef PG8_SCHED
}
}
namespace da {
constexpr int D = 128;
constexpr int LDI = 128, LDO = 2048;
constexpr float THR = 8.f;
constexpr bool WSKIP = false;
constexpr float SCALE = 0.08838834764831845f;
constexpr int NW = 8, QBLK = 32, KVBLK = 64, QB = NW * QBLK;
constexpr int SHM_V = KVBLK * D * 2, SHM_K = KVBLK * D * 2;
constexpr int LDS_BYTES = 2 * SHM_V + 2 * SHM_K + NW * 64 * 4;

using bf16 = __hip_bfloat16;
typedef short bf16x8 __attribute__((ext_vector_type(8)));
typedef short s16x4 __attribute__((ext_vector_type(4)));
typedef float f32x16 __attribute__((ext_vector_type(16)));
typedef float f32x4 __attribute__((ext_vector_type(4)));
typedef unsigned u32x4 __attribute__((ext_vector_type(4)));
template <class A, class Bt> struct same_t { static constexpr bool v = false; };
template <class A> struct same_t<A, A> { static constexpr bool v = true; };

#define KSWZ(row, colB) ((row) * 256 + ((colB) ^ (((row) & 7) << 4)))
#define SBAR() __builtin_amdgcn_sched_barrier(0)
__device__ __forceinline__ int v_st(int k, int c) { const int kk = (k & ~0xC) | ((k & 4) << 1) | ((k & 8) >> 1); return ((kk >> 3) * 4 + (c >> 5)) * 512 + ((kk & 7) * 32 + (c & 31)) * 2; }
__device__ __forceinline__ int v_rd_base(int lane) { return ((lane & 3) << 3) | (((lane >> 2) & 3) << 6) | (((lane >> 4) & 1) << 5) | (((lane >> 5) & 1) << 8); }
constexpr int v_rd_off(int d0, int ks, int half) { return d0 * 512 + ks * 4096 + half * 2048; }
__device__ __forceinline__ int crow(int r, int hi) { return (r & 3) + 8 * (r >> 2) + 4 * hi; }
__device__ __forceinline__ unsigned cvtpk(float lo, float hi) {
    unsigned r; asm volatile("v_cvt_pk_bf16_f32 %0, %1, %2" : "=v"(r) : "v"(lo), "v"(hi)); return r;
}
__device__ __forceinline__ bf16x8 pack8(f32x4 a, f32x4 b) {
    u32x4 w = {cvtpk(a[0], a[1]), cvtpk(a[2], a[3]), cvtpk(b[0], b[1]), cvtpk(b[2], b[3])};
    return *reinterpret_cast<bf16x8*>(&w);
}
template <class T> __device__ __forceinline__ bf16x8 load8(const T* p) {
    if constexpr (same_t<T, float>::v) { return pack8(*(const f32x4*)p, *(const f32x4*)(p + 4)); }
    else { return *reinterpret_cast<const bf16x8*>(p); }
}
__device__ __forceinline__ void mask_tile(f32x16& p0, f32x16& p1, int dq, unsigned W) {
    const float NEG = -__builtin_inff();
#pragma unroll
    for (int r = 0; r < 16; ++r) {
        const int c = (r & 3) + 8 * (r >> 2);
        if ((unsigned)(dq - c) >= W) p0[r] = NEG;
        if ((unsigned)(dq - c - 32) >= W) p1[r] = NEG;
    }
}
__device__ __forceinline__ void partialSM(f32x16& p0, f32x16& p1, float& m_reg, float& mn, float& alpha) {
    float pmax = p0[0]; for (int r = 1; r < 16; ++r) pmax = fmaxf(pmax, p0[r]); for (int r = 0; r < 16; ++r) pmax = fmaxf(pmax, p1[r]);
    { auto rr = __builtin_amdgcn_permlane32_swap(__float_as_uint(pmax), __float_as_uint(pmax), false, false);
      pmax = fmaxf(__uint_as_float(rr[0]), __uint_as_float(rr[1])); }
    constexpr float C2 = 1.4426950408889634f * SCALE;
    if (__builtin_expect(__all((pmax - m_reg) * SCALE <= THR), 1)) { mn = m_reg; alpha = 1.f; }
    else { mn = fmaxf(m_reg, pmax); alpha = __builtin_amdgcn_exp2f((m_reg - mn) * C2); m_reg = mn; }
    const float mnL = -mn * C2;
    for (int r = 0; r < 16; ++r) p0[r] = fmaf(p0[r], C2, mnL); for (int r = 0; r < 16; ++r) p1[r] = fmaf(p1[r], C2, mnL);
    for (int r = 0; r < 16; ++r) p0[r] = __builtin_amdgcn_exp2f(p0[r]);
}
__device__ __forceinline__ void finishSM(f32x16& p0, f32x16& p1, float alpha, float& l_reg, bf16x8& pa0, bf16x8& pa1, bf16x8& pa2, bf16x8& pa3) {
    for (int r = 0; r < 16; ++r) p1[r] = __builtin_amdgcn_exp2f(p1[r]);
    float ps = 0; for (int r = 0; r < 16; ++r) ps += p0[r]; for (int r = 0; r < 16; ++r) ps += p1[r];
    { auto rr = __builtin_amdgcn_permlane32_swap(__float_as_uint(ps), __float_as_uint(ps), false, false);
      ps = __uint_as_float(rr[0]) + __uint_as_float(rr[1]); }
    l_reg = l_reg * alpha + ps;
#define PK4(P, B_, OUT) do { unsigned a0 = cvtpk(P[B_+0], P[B_+1]), a1 = cvtpk(P[B_+2], P[B_+3]);                          \
        unsigned b0 = cvtpk(P[B_+4], P[B_+5]), b1 = cvtpk(P[B_+6], P[B_+7]);                                             \
        auto r0 = __builtin_amdgcn_permlane32_swap(a0, b0, false, false); auto r1 = __builtin_amdgcn_permlane32_swap(a1, b1, false, false); \
        u32x4 w = {r0[0], r1[0], r0[1], r1[1]}; OUT = *reinterpret_cast<bf16x8*>(&w); } while (0)
    PK4(p0, 0, pa0); PK4(p0, 8, pa1); PK4(p1, 0, pa2); PK4(p1, 8, pa3);
#undef PK4
}
template <int KB, bool SK>
__device__ __forceinline__ void qkt(f32x16& p0, f32x16& p1, const char* K_lds, int r32, int hi, const bf16x8* qr, bool act) {
    if (SK && !act) { const float NEG = -__builtin_inff();
#pragma unroll
        for (int r = 0; r < 16; ++r) { p0[r] = NEG; p1[r] = NEG; } return; }
    p0 = f32x16{}; p1 = f32x16{};
    const char* kb[4];
#pragma unroll
    for (int dd = 0; dd < 4; ++dd) kb[dd] = K_lds + KB * SHM_K + KSWZ(r32, (dd * 16 + hi * 8) * 2);
#pragma unroll
    for (int d0 = 0; d0 < 8; ++d0) { const char* a = kb[d0 & 3] + (d0 >> 2) * 128;
        bf16x8 b0 = *reinterpret_cast<const bf16x8*>(a);
        bf16x8 b1 = *reinterpret_cast<const bf16x8*>(a + 32 * 256);
        p0 = __builtin_amdgcn_mfma_f32_32x32x16_bf16(b0, qr[d0], p0, 0, 0, 0);
        p1 = __builtin_amdgcn_mfma_f32_32x32x16_bf16(b1, qr[d0], p1, 0, 0, 0); }
}
template <int VB, bool SK>
__device__ __forceinline__ void pv_tile(f32x16* o, int vb0, bf16x8 pa0, bf16x8 pa1, bf16x8 pa2, bf16x8 pa3, bool act) {
    if (SK && !act) return;
#define TRRD(dst, off) asm volatile("ds_read_b64_tr_b16 %0, %1 offset:%2" : "=&v"(dst) : "v"(vb0), "i"(off) : "memory")
#define PV_D0(d0) do { s16x4 l0, l1, l2, l3, h0, h1, h2, h3; constexpr int b_ = VB * SHM_V + v_rd_off(d0, 0, 0);     \
        TRRD(l0, b_); TRRD(h0, b_ + 2048); TRRD(l1, b_ + 4096); TRRD(h1, b_ + 6144); TRRD(l2, b_ + 8192); TRRD(h2, b_ + 10240); TRRD(l3, b_ + 12288); TRRD(h3, b_ + 14336); \
        asm volatile("s_waitcnt lgkmcnt(0)" ::: "memory"); SBAR();                 \
        o[d0] = __builtin_amdgcn_mfma_f32_32x32x16_bf16(pa0, (bf16x8){l0[0], l0[1], l0[2], l0[3], h0[0], h0[1], h0[2], h0[3]}, o[d0], 0, 0, 0);   \
        o[d0] = __builtin_amdgcn_mfma_f32_32x32x16_bf16(pa1, (bf16x8){l1[0], l1[1], l1[2], l1[3], h1[0], h1[1], h1[2], h1[3]}, o[d0], 0, 0, 0);   \
        o[d0] = __builtin_amdgcn_mfma_f32_32x32x16_bf16(pa2, (bf16x8){l2[0], l2[1], l2[2], l2[3], h2[0], h2[1], h2[2], h2[3]}, o[d0], 0, 0, 0);   \
        o[d0] = __builtin_amdgcn_mfma_f32_32x32x16_bf16(pa3, (bf16x8){l3[0], l3[1], l3[2], l3[3], h3[0], h3[1], h3[2], h3[3]}, o[d0], 0, 0, 0); } while (0)
    PV_D0(0); PV_D0(1); PV_D0(2); PV_D0(3);
#undef PV_D0
#undef TRRD
}

template <class TIn, class TOut> struct BlockRef { const TIn* Q; const TIn* K; const TIn* V; TOut* O; int P0; };
template <class TIn> struct Seam {
    bf16x8 qr[8];
    bf16x8 st_v0, st_v1, st_k0, st_k1; f32x4 sf0, sf1, sf2, sf3;
    f32x4 tq[16];
};
__device__ __forceinline__ int swa_jlo(int P0, int W) { const int lowk = P0 - W + 1; return lowk > 0 ? lowk / KVBLK : 0; }
#define ROW(p, k0, rr) ((p) + (size_t)((k0) + (rr)) * LDI + sc)
#define VMW() asm volatile("s_waitcnt vmcnt(0)" ::: "memory")
#define VMWN(n) asm volatile("s_waitcnt vmcnt(%0)" :: "i"(n) : "memory")
#define SLOAD_H(Kp, Vp, k0) do { S.st_v0 = load8<TIn>(ROW(Vp, k0, sr)); S.st_v1 = load8<TIn>(ROW(Vp, k0, 32 + sr));              \
                         S.st_k0 = load8<TIn>(ROW(Kp, k0, sr)); S.st_k1 = load8<TIn>(ROW(Kp, k0, 32 + sr)); } while (0)
#define SWRITE_HK(bf) do { *(bf16x8*)(K_lds + (bf) * SHM_K + kws) = S.st_k0; *(bf16x8*)(K_lds + (bf) * SHM_K + kws + 32 * 256) = S.st_k1; } while (0)
#define SWRITE_HV(bf) do { *(bf16x8*)(V_lds + (bf) * SHM_V + vst0) = S.st_v0; *(bf16x8*)(V_lds + (bf) * SHM_V + vst1) = S.st_v1; } while (0)
#define SWRITE_H(bf) do { SWRITE_HV(bf); SWRITE_HK(bf); } while (0)
#define SLOAD_F(p, k0) do { S.sf0 = *(const f32x4*)ROW(p, k0, sr); S.sf1 = *(const f32x4*)(ROW(p, k0, sr) + 4);                \
                            S.sf2 = *(const f32x4*)ROW(p, k0, 32 + sr); S.sf3 = *(const f32x4*)(ROW(p, k0, 32 + sr) + 4); } while (0)
#define SWRITE_KF(bf) do { *(bf16x8*)(K_lds + (bf) * SHM_K + kws) = pack8(S.sf0, S.sf1); *(bf16x8*)(K_lds + (bf) * SHM_K + kws + 32 * 256) = pack8(S.sf2, S.sf3); } while (0)
#define SWRITE_VF(bf) do { *(bf16x8*)(V_lds + (bf) * SHM_V + vst0) = pack8(S.sf0, S.sf1); *(bf16x8*)(V_lds + (bf) * SHM_V + vst1) = pack8(S.sf2, S.sf3); } while (0)
template <class TIn, class TOut>
__device__ __forceinline__ void causal_swa_prime(const BlockRef<TIn, TOut>& cur, int W, char* lds, Seam<TIn>& S) {
    constexpr bool F32 = same_t<TIn, float>::v;
    const int tid = opq_tid(), wid = __builtin_amdgcn_readfirstlane(tid >> 6), lane = tid & 63, r32 = lane & 31, hi = lane >> 5;
    const int sr = tid >> 4, sc = (tid & 15) * 8, kws = KSWZ(sr, sc * 2); char* K_lds = lds + 2 * SHM_V;
    const int kb0 = swa_jlo(cur.P0, W) * KVBLK;
    for (int d0 = 0; d0 < 8; ++d0) S.qr[d0] = load8<TIn>(cur.Q + (size_t)(wid * QBLK + r32) * LDI + d0 * 16 + hi * 8);
    if constexpr (F32) { SLOAD_F((const float*)cur.K, kb0); VMW(); SWRITE_KF(0); SBAR(); SLOAD_F((const float*)cur.V, kb0); }
    else { SLOAD_H(cur.K, cur.V, kb0); VMW(); SWRITE_HK(0); }
    __syncthreads();
}
template <class TIn, class TOut>
__device__ __forceinline__ void causal_swa_block(const BlockRef<TIn, TOut>& cur, const BlockRef<TIn, TOut>& nxt, int skv, int W, char* lds, Seam<TIn>& S) {
    constexpr bool F32 = same_t<TIn, float>::v;
    const int tid = opq_tid(), wid = __builtin_amdgcn_readfirstlane(tid >> 6), lane = tid & 63, r32 = lane & 31, hi = lane >> 5;
    const int j_lo = swa_jlo(cur.P0, W);
    int j_hi = (cur.P0 + QB - 1) / KVBLK + 1; if (j_hi > skv / KVBLK) j_hi = skv / KVBLK;
    const int NT = j_hi - j_lo;
    const int kbn = swa_jlo(nxt.P0, W) * KVBLK;
    const int qlo = cur.P0 + wid * QBLK, qm = qlo + r32 - 4 * hi;
    char* V_lds = lds; char* K_lds = lds + 2 * SHM_V;
    float* ws = (float*)(lds + 2 * SHM_V + 2 * SHM_K) + wid * 64; float* li_l = ws, * al_l = ws + 32;
    float m_reg = -1e30f, l_reg = 0; f32x16 o[4] = {};
    const int sr = tid >> 4, sc = (tid & 15) * 8, vst0 = v_st(sr, sc), vst1 = v_st(32 + sr, sc), kws = KSWZ(sr, sc * 2);
    const int vb0 = (int)(uintptr_t)V_lds + v_rd_base(lane);
    const TIn* Kh = cur.K; const TIn* Vh = cur.V;
#define RESC(a) do { if (__any((a) < 1.f)) { if (hi == 0) al_l[r32] = (a); asm volatile("s_waitcnt lgkmcnt(0)" ::: "memory");              \
                     for (int d_ = 0; d_ < 4; ++d_) for (int r = 0; r < 16; ++r) o[d_][r] *= al_l[crow(r, hi)]; } } while (0)
#define KBASE(t) ((j_lo + (t)) * KVBLK)
#define ACT(t) (KBASE(t) <= qlo + QBLK - 1 && KBASE(t) + KVBLK - 1 >= qlo - W + 1)
#define MASKT(P0_, P1_, t) do { const int kb_ = KBASE(t); if ((!SK || ACT(t)) && (kb_ + KVBLK - 1 > qlo || kb_ <= qlo + QBLK - 1 - W)) mask_tile(P0_, P1_, qm - kb_, (unsigned)W); } while (0)
    constexpr int NQL = F32 ? 16 : 8;
    constexpr bool SK = WSKIP && !F32;
#define SEAM_K0() do { VMWN(NQL); if constexpr (F32) { SWRITE_KF(0); SBAR(); SLOAD_F((const float*)nxt.V, kbn); } else { SWRITE_HK(0); } SBAR(); } while (0)
    f32x16 pA0, pA1, pB0, pB1; float mnA, mnB, alA, alB; bf16x8 pa0, pa1, pa2, pa3;
    if constexpr (F32) { VMW(); SWRITE_VF(0); SBAR(); } else { SWRITE_HV(0); SBAR(); }
    if (NT > 1) { if constexpr (F32) SLOAD_F((const float*)Kh, KBASE(1)); else SLOAD_H(Kh, Vh, KBASE(1)); }
    SBAR(); qkt<0, SK>(pA0, pA1, K_lds, r32, hi, S.qr, ACT(0));
    if constexpr (F32) { if (NT > 1) { VMW(); SWRITE_KF(1); SBAR(); SLOAD_F((const float*)Vh, KBASE(1)); } }
    MASKT(pA0, pA1, 0); partialSM(pA0, pA1, m_reg, mnA, alA);
    if (NT > 1) { VMW(); if constexpr (F32) { SWRITE_VF(1); SBAR(); if (NT > 2) SLOAD_F((const float*)Kh, KBASE(2)); } else SWRITE_H(1); }
    __syncthreads();
#define HALF_STEP(PX0, PX1, mnX, alX, PY0, PY1, alY, t, KB, VB, SB) do {                                                      \
        SBAR(); qkt<KB, SK>(PX0, PX1, K_lds, r32, hi, S.qr, ACT(t));                                             \
        finishSM(PY0, PY1, alY, l_reg, pa0, pa1, pa2, pa3); SBAR();                                                           \
        if ((t) + 1 < NT) { if constexpr (F32) { VMW(); SWRITE_KF(SB); SBAR(); SLOAD_F((const float*)Vh, KBASE((t) + 1)); }  \
                            else { SLOAD_H(Kh, Vh, KBASE((t) + 1)); } SBAR(); }                                               \
        pv_tile<VB, SK>(o, vb0, pa0, pa1, pa2, pa3, ACT((t) - 1)); MASKT(PX0, PX1, (t)); partialSM(PX0, PX1, m_reg, mnX, alX);                                        \
        __syncthreads();                                                                                                      \
        if ((t) + 1 < NT) { VMW(); if constexpr (F32) { SWRITE_VF(SB); SBAR(); if ((t) + 2 < NT) SLOAD_F((const float*)Kh, KBASE((t) + 2)); } \
                            else { SWRITE_H(SB); } }                                                                          \
        RESC(alX); __syncthreads(); } while (0)
    for (int t = 1; t + 1 < NT; t += 2) {
        HALF_STEP(pB0, pB1, mnB, alB, pA0, pA1, alA, t, 1, 0, 0);
        HALF_STEP(pA0, pA1, mnA, alA, pB0, pB1, alB, t + 1, 0, 1, 1);
    }
    const bool even = (NT & 1) == 0;
    if (even) { SBAR(); qkt<1, SK>(pB0, pB1, K_lds, r32, hi, S.qr, ACT(NT - 1)); SBAR(); }
#define QROW(e) (nxt.Q + (size_t)(wid * QBLK + r32) * LDI + ((e) >> 1) * 16 + hi * 8 + ((e) & 1) * 4)
    if constexpr (F32) { SLOAD_F((const float*)nxt.K, kbn); SBAR();
#pragma unroll
        for (int e = 0; e < 8; ++e) S.tq[e] = *(const f32x4*)QROW(e); }
    else { SLOAD_H(nxt.K, nxt.V, kbn); SBAR();
#pragma unroll
        for (int d0 = 0; d0 < 8; ++d0) S.qr[d0] = load8<TIn>(nxt.Q + (size_t)(wid * QBLK + r32) * LDI + d0 * 16 + hi * 8); }
    SBAR();
    finishSM(pA0, pA1, alA, l_reg, pa0, pa1, pa2, pa3); SBAR();
    if constexpr (F32) {
#pragma unroll
        for (int e = 8; e < 16; ++e) S.tq[e] = *(const f32x4*)QROW(e); SBAR(); }
#undef QROW
    pv_tile<0, SK>(o, vb0, pa0, pa1, pa2, pa3, ACT(even ? NT - 2 : NT - 1));
    if (even) { MASKT(pB0, pB1, NT - 1); partialSM(pB0, pB1, m_reg, mnB, alB); __syncthreads(); RESC(alB);
        finishSM(pB0, pB1, alB, l_reg, pa0, pa1, pa2, pa3); SBAR(); pv_tile<1, SK>(o, vb0, pa0, pa1, pa2, pa3, ACT(NT - 1)); }
    SBAR(); SEAM_K0();
    if (hi == 0) li_l[r32] = l_reg; asm volatile("s_waitcnt lgkmcnt(0)" ::: "memory");
    float rli[16];
#pragma unroll
    for (int r = 0; r < 16; ++r) rli[r] = __builtin_amdgcn_rcpf(li_l[crow(r, hi)]);
    TOut* Ow = cur.O + (size_t)(wid * QBLK) * LDO;
#pragma unroll
    for (int r = 0; r < 16; ++r) { const int orow = crow(r, hi);
#pragma unroll
        for (int d0 = 0; d0 < 4; ++d0) { const float v = o[d0][r] * rli[r];
            if constexpr (same_t<TOut, float>::v) { Ow[(size_t)orow * LDO + d0 * 32 + r32] = v; }
            else { const float vn = __shfl_xor(v, 1);
                   if ((r32 & 1) == 0) *(unsigned*)(Ow + (size_t)orow * LDO + d0 * 32 + r32) = cvtpk(v, vn); } } }
    if constexpr (F32) {
#pragma unroll
        for (int d0 = 0; d0 < 8; ++d0) S.qr[d0] = pack8(S.tq[2 * d0], S.tq[2 * d0 + 1]); }
    __syncthreads();
#undef RESC
#undef KBASE
#undef ACT
#undef MASKT
#undef SEAM_K0
#undef HALF_STEP
}
#undef ROW
#undef VMW
#undef VMWN
#undef SLOAD_H
#undef SWRITE_HK
#undef SWRITE_HV
#undef SWRITE_H
#undef SLOAD_F
#undef SWRITE_KF
#undef SWRITE_VF
}

typedef unsigned short u16;
typedef short bf16x8_t __attribute__((ext_vector_type(8)));
typedef float f32x4_t __attribute__((ext_vector_type(4)));
typedef unsigned u32x4_t __attribute__((ext_vector_type(4)));

constexpr int T_ = 16384, S_ = 4096, DM = 2048, DFF = 5504, NGU = 11008, NPJ = 7168, PW = 7176;
constexpr int NTHR = 512;
constexpr size_t PBLK = (size_t)T_ * 128;
constexpr int LDT = 136;

constexpr size_t OFF_TAB = 0;
constexpr size_t SZ_TAB = (size_t)4096 * 64 * 4 * 2 + (size_t)4096 * 16 * 4 * 2;
constexpr size_t OFF_WGU1 = OFF_TAB + SZ_TAB;
constexpr size_t SZ_WGU = (size_t)NGU * DM * 2;
constexpr size_t OFF_WD1 = OFF_WGU1 + SZ_WGU;
constexpr size_t SZ_WD = (size_t)DM * DFF * 2;
constexpr size_t OFF_WIN = OFF_WD1 + SZ_WD;
constexpr size_t SZ_WIN = (size_t)NPJ * DM * 2;
constexpr size_t OFF_WOUT = OFF_WIN + SZ_WIN;
constexpr size_t SZ_WOUT = (size_t)DM * DM * 2;
constexpr size_t OFF_WGU2 = OFF_WOUT + SZ_WOUT;
constexpr size_t OFF_WD2 = OFF_WGU2 + SZ_WGU;
constexpr size_t OFF_XB = OFF_WD2 + SZ_WD;
constexpr size_t SZ_XB = (size_t)T_ * DM * 2;
constexpr size_t OFF_HP = OFF_XB + SZ_XB;
constexpr size_t SZ_HP = (size_t)T_ * NPJ * 2;
constexpr size_t OFF_Z = OFF_HP + SZ_HP;
constexpr size_t SZ_Z = (size_t)T_ * DM * 4;
constexpr size_t OFF_GATE = OFF_Z + SZ_Z;
constexpr size_t SZ_GATE = (size_t)T_ * 8 * 4;
constexpr size_t OFF_MQK = OFF_GATE + SZ_GATE;
constexpr size_t SZ_MQK = (size_t)T_ * 1024 * 2;
constexpr size_t OFF_STR = OFF_MQK + SZ_MQK;
constexpr size_t SZ_STR = (size_t)16 * 32 * 16384 * 4;
constexpr size_t OFF_STM = OFF_STR + SZ_STR;
constexpr size_t SZ_STM = (size_t)16 * 64 * 16384 * 4;
constexpr size_t OFF_NM = OFF_STM + SZ_STM;
constexpr size_t SZ_NM = (size_t)16 * 64 * 128 * 4;
constexpr size_t OFF_SC = OFF_NM + SZ_NM;
constexpr size_t SZ_SC = (size_t)16 * 64 * 4 * 4;
constexpr size_t OFF_MIX = OFF_SC + SZ_SC;
constexpr size_t SZ_MIX = (size_t)T_ * DM * 2;
constexpr size_t OFF_STAT = OFF_MIX + SZ_MIX;
constexpr size_t SZ_STAT = (size_t)6 * T_ * 2 * 4;
constexpr size_t OFF_CS = OFF_STAT + SZ_STAT;
constexpr int CS_LAYER = 2 * NPJ + 4 * NGU;
constexpr size_t SZ_CS = (size_t)2 * CS_LAYER * 4;
constexpr size_t OFF_BAR = OFF_CS + SZ_CS;
constexpr size_t SZ_BAR = 16384;
constexpr size_t WS_END = OFF_BAR + SZ_BAR;

constexpr int LDS_PHASE = 4 * 128 * LDT * 2 + 7 * 128 * 4;
constexpr int LDS_TOTAL = LDS_PHASE + 16;

struct Params { const float* in[16]; float* out; unsigned char* ws; };

__device__ __forceinline__ u16 f2bf(float f) { return (u16)(pg8::cvt_pk_bf16(f, 0.f) & 0xffffu); }
__device__ __forceinline__ float bf2f(u16 b) { return __uint_as_float(((unsigned)b) << 16); }
__device__ __forceinline__ unsigned pk2(float a, float b) { return pg8::cvt_pk_bf16(a, b); }
__device__ __forceinline__ float shx(float v, int o, int lane) { return __int_as_float(__builtin_amdgcn_ds_bpermute((lane ^ o) << 2, __float_as_int(v))); }
__device__ __forceinline__ float shup(float v, int o, int lane) { return __int_as_float(__builtin_amdgcn_ds_bpermute(((lane - o) & 63) << 2, __float_as_int(v))); }
__device__ __forceinline__ float dpp_f(float v, int ctrl_sel) {
    const int x = __float_as_int(v);
    int r;
    if (ctrl_sel == 0) r = __builtin_amdgcn_update_dpp(x, x, 0xB1, 0xF, 0xF, false);
    else if (ctrl_sel == 1) r = __builtin_amdgcn_update_dpp(x, x, 0x4E, 0xF, 0xF, false);
    else if (ctrl_sel == 2) r = __builtin_amdgcn_update_dpp(x, x, 0x124, 0xF, 0xF, false);
    else r = __builtin_amdgcn_update_dpp(x, x, 0x128, 0xF, 0xF, false);
    return __int_as_float(r);
}
__device__ __forceinline__ float wave_sum(float v, int lane) {
    (void)lane;
    v += dpp_f(v, 0); v += dpp_f(v, 1); v += dpp_f(v, 2); v += dpp_f(v, 3);
    const int x = __float_as_int(v);
    return (__int_as_float(__builtin_amdgcn_readlane(x, 0)) + __int_as_float(__builtin_amdgcn_readlane(x, 16))) + (__int_as_float(__builtin_amdgcn_readlane(x, 32)) + __int_as_float(__builtin_amdgcn_readlane(x, 48)));
}
__device__ __forceinline__ float wave_max(float v, int lane) {
    (void)lane;
    v = fmaxf(v, dpp_f(v, 0)); v = fmaxf(v, dpp_f(v, 1)); v = fmaxf(v, dpp_f(v, 2)); v = fmaxf(v, dpp_f(v, 3));
    const int x = __float_as_int(v);
    return fmaxf(fmaxf(__int_as_float(__builtin_amdgcn_readlane(x, 0)), __int_as_float(__builtin_amdgcn_readlane(x, 16))), fmaxf(__int_as_float(__builtin_amdgcn_readlane(x, 32)), __int_as_float(__builtin_amdgcn_readlane(x, 48))));
}
__device__ __forceinline__ float scan_sum(float v, int lane) {
#pragma unroll
    for (int o = 1; o < 64; o <<= 1) { const float t = shup(v, o, lane); if (lane >= o) v += t; }
    return v;
}
__device__ __forceinline__ float scan_max(float v, int lane) {
#pragma unroll
    for (int o = 1; o < 64; o <<= 1) { const float t = shup(v, o, lane); if (lane >= o) v = fmaxf(v, t); }
    return v;
}
__device__ __forceinline__ float silu_f(float x) { return x * __builtin_amdgcn_rcpf(1.0f + __expf(-x)); }
__device__ __forceinline__ float sigmoid_f(float x) { return __builtin_amdgcn_rcpf(1.0f + __expf(-x)); }
__device__ __forceinline__ float log1p01(float e) {
    const float s = e / (2.0f + e), s2 = s * s;
    return 2.0f * s * (1.0f + s2 * (0.333333333f + s2 * (0.2f + s2 * (0.142857143f + s2 * (0.111111111f + s2 * 0.0909090909f)))));
}
__device__ __forceinline__ float logsig_f(float x) { return x >= 0.f ? -log1p01(__expf(-x)) : x - log1p01(__expf(x)); }
__device__ __forceinline__ float ret_logg(int h) {
    return h == 0 ? -0.031748698314580301f : (h == 1 ? -0.015748356968139168f : (h == 2 ? -0.0078431774610258787f : -0.0039138993211363287f));
}

__device__ __forceinline__ void phase_init(const Params& p) {
    const int gtid = opq_bid() * NTHR + opq_tid(), gn = opq_gdim() * NTHR;
    float* retc = (float*)(p.ws + OFF_TAB); float* rets = retc + 4096 * 64; float* difc = rets + 4096 * 64; float* difs = difc + 4096 * 16;
    for (int i = gtid; i < 4096 * 64; i += gn) {
        const int pos = i >> 6, j = i & 63; const float inv = powf(10000.0f, -(float)(2 * j) / 128.0f); const float ang = (float)pos * inv;
        retc[i] = cosf(ang); rets[i] = sinf(ang); }
    for (int i = gtid; i < 4096 * 16; i += gn) {
        const int pos = i >> 4, j = i & 15; const float inv = powf(500000.0f, -(float)(2 * j) / 32.0f); const float ang = (float)pos * inv;
        difc[i] = cosf(ang); difs[i] = sinf(ang); }
    const float4* x4 = (const float4*)p.in[0]; uint2* xb = (uint2*)(p.ws + OFF_XB);
    for (int i0 = gtid; i0 < T_ * DM / 4; i0 += 4 * gn) {
        float4 v[4];
#pragma unroll
        for (int e = 0; e < 4; ++e) v[e] = (i0 + e * gn < T_ * DM / 4) ? x4[i0 + e * gn] : make_float4(0.f, 0.f, 0.f, 0.f);
#pragma unroll
        for (int e = 0; e < 4; ++e) if (i0 + e * gn < T_ * DM / 4) { uint2 w; w.x = pk2(v[e].x, v[e].y); w.y = pk2(v[e].z, v[e].w); xb[i0 + e * gn] = w; }
    }
    float* zero = (float*)(p.ws + OFF_CS);
    for (int i = gtid; i < (int)(SZ_CS / 4); i += gn) zero[i] = 0.f;
}

__device__ __forceinline__ int win_row(int n) {
    const int pn = n >> 8, c = n & 255, g = c >> 7, j = c & 127;
    if (pn < 4) return 256 * pn + 128 * (j >> 6) + 64 * g + (j & 63);
    if (pn >= 8 && pn < 16) {
        if (j < 16) return 256 * pn + 16 * g + j;
        if (j < 32) return 256 * pn + 128 + 16 * g + (j - 16);
        if (j < 80) return 256 * pn + 32 + 48 * g + (j - 32);
        return 256 * pn + 128 + 32 + 48 * g + (j - 80);
    }
    return n;
}
template <int MODE>
__device__ __forceinline__ void convert_T(const float* __restrict__ W, int K, int ldn, int ncols, u16* __restrict__ Wt, float* tile) {
    const int tk = K / 64, tn = ncols / 64, nt = tk * tn, t = opq_tid();
    const int per = (nt + opq_gdim() - 1) / opq_gdim(), t0 = opq_bid() * per, t1 = (t0 + per < nt) ? t0 + per : nt;
    if (t0 >= t1) return;
    const int lr = t >> 4, lc = (t & 15) * 4;
    const int nn = t >> 3, k8 = (t & 7) * 8;
    f32x4_t ra[4], rb[4];
#define CT_LOAD(d, tix) do { const int k_ = ((tix) / tn) * 64, n_ = ((tix) % tn) * 64; const float* s_ = W + (size_t)(k_ + lr) * ldn + n_ + lc; ra[d] = *(const f32x4_t*)s_; rb[d] = *(const f32x4_t*)(s_ + (size_t)32 * ldn); } while (0)
    CT_LOAD(0, t0);
    if (t0 + 1 < t1) CT_LOAD(1, t0 + 1);
    if (t0 + 2 < t1) CT_LOAD(2, t0 + 2);
    for (int ti = t0; ti < t1; ++ti) {
        const int k0 = (ti / tn) * 64, n0 = (ti % tn) * 64;
        if (ti + 3 < t1) CT_LOAD(3, ti + 3);
        __syncthreads();
#pragma unroll
        for (int e = 0; e < 4; ++e) { tile[lr * 65 + lc + e] = ra[0][e]; tile[(lr + 32) * 65 + lc + e] = rb[0][e]; }
        __syncthreads();
        float wv[8];
#pragma unroll
        for (int j = 0; j < 8; ++j) wv[j] = tile[(k8 + j) * 65 + nn];
        const int n = n0 + nn;
        const int row = MODE == 0 ? n : (MODE == 1 ? (256 * ((n % DFF) / 128) + 128 * (n / DFF) + (n % 128)) : win_row(n));
        uint4 w; w.x = pk2(wv[0], wv[1]); w.y = pk2(wv[2], wv[3]); w.z = pk2(wv[4], wv[5]); w.w = pk2(wv[6], wv[7]);
        *(uint4*)(Wt + (size_t)row * K + k0 + k8) = w;
#pragma unroll
        for (int d = 0; d < 3; ++d) { ra[d] = ra[d + 1]; rb[d] = rb[d + 1]; }
    }
#undef CT_LOAD
}
__device__ __forceinline__ void phase_weights(const Params& p, int l, unsigned char* lds) {
    float* tile = (float*)lds;
    convert_T<1>(p.in[3] + (size_t)l * DM * NGU, DM, NGU, NGU, (u16*)(p.ws + OFF_WGU1), tile);
    convert_T<0>(p.in[4] + (size_t)l * DFF * DM, DFF, DM, DM, (u16*)(p.ws + OFF_WD1), tile);
    convert_T<2>(p.in[5] + (size_t)l * DM * PW, DM, PW, NPJ, (u16*)(p.ws + OFF_WIN), tile);
    convert_T<0>(p.in[13] + (size_t)l * DM * DM, DM, DM, DM, (u16*)(p.ws + OFF_WOUT), tile);
    convert_T<1>(p.in[14] + (size_t)l * DM * NGU, DM, NGU, NGU, (u16*)(p.ws + OFF_WGU2), tile);
    convert_T<0>(p.in[15] + (size_t)l * DFF * DM, DFF, DM, DM, (u16*)(p.ws + OFF_WD2), tile);
}

__device__ __forceinline__ void row_mr(const float* st, int row, float& mean, float& rstd) { const float2 v = *(const float2*)(st + (size_t)row * 2); mean = v.x; rstd = v.y; }
struct EpiSwiGLU {
    static constexpr bool PERM = true, AFTER_DRAIN = false;
    u16* H;
    __device__ __forceinline__ void operator()(const pg8::f32x4 (&acc)[2][2][4][2], const pg8::Unit& u, int wr, int wc, int fr, int fq) const {
        const int row0 = u.pm * 256 + wr * 64 + fr, col0 = u.pn * 128 + wc * 32 + 8 * fq;
#pragma unroll
        for (int ai = 0; ai < 2; ++ai)
#pragma unroll
            for (int m = 0; m < 4; ++m) {
                u16* rowp = H + (size_t)(row0 + ai * 128 + m * 16) * DFF + col0;
                const pg8::f32x4 g0 = acc[ai][0][m][0], g1 = acc[ai][0][m][1], u0 = acc[ai][1][m][0], u1 = acc[ai][1][m][1];
                float h[8];
#pragma unroll
                for (int j = 0; j < 4; ++j) { h[j] = silu_f(g0[j]) * u0[j]; h[4 + j] = silu_f(g1[j]) * u1[j]; }
                pg8::u32x4 w; w.x = pg8::cvt_pk_bf16(h[0], h[1]); w.y = pg8::cvt_pk_bf16(h[2], h[3]); w.z = pg8::cvt_pk_bf16(h[4], h[5]); w.w = pg8::cvt_pk_bf16(h[6], h[7]);
                *(pg8::u32x4*)rowp = w;
            }
    }
};
struct EpiProjBM {
    static constexpr bool PERM = true, AFTER_DRAIN = false;
    u16* O; const float* tab;
    __device__ __forceinline__ static void st8(u16* p, const pg8::f32x4& a, const pg8::f32x4& b) {
        pg8::u32x4 w; w.x = pg8::cvt_pk_bf16(a[0], a[1]); w.y = pg8::cvt_pk_bf16(a[2], a[3]); w.z = pg8::cvt_pk_bf16(b[0], b[1]); w.w = pg8::cvt_pk_bf16(b[2], b[3]);
        *(pg8::u32x4*)p = w;
    }
    __device__ __forceinline__ void operator()(const pg8::f32x4 (&acc)[2][2][4][2], const pg8::Unit& u, int wr, int wc, int fr, int fq) const {
        const int row0 = u.pm * 256 + wr * 64 + fr, x0 = wc * 32 + 8 * fq;
        const bool ret_u = u.pn < 4, dif_u = u.pn >= 8 && u.pn < 16;
        if (ret_u) {
            const int head = x0 >> 6, jj = x0 & 63; const float sc = u.pn >= 2 ? 0.08838834764831845f : 1.0f;
            u16* blk = O + (size_t)(2 * u.pn + head) * PBLK + jj;
#pragma unroll
            for (int ai = 0; ai < 2; ++ai)
#pragma unroll
                for (int m = 0; m < 4; ++m) {
                    const int row = row0 + ai * 128 + m * 16; const float* ct = tab + (size_t)(row & 4095) * 64 + jj; const float* st = ct + 4096 * 64;
                    const pg8::f32x4 c0 = *(const pg8::f32x4*)ct, c1 = *(const pg8::f32x4*)(ct + 4), s0 = *(const pg8::f32x4*)st, s1 = *(const pg8::f32x4*)(st + 4);
                    const pg8::f32x4 a0 = acc[ai][0][m][0], a1 = acc[ai][0][m][1], b0 = acc[ai][1][m][0], b1 = acc[ai][1][m][1];
                    st8(blk + (size_t)row * 128, (a0 * c0 - b0 * s0) * sc, (a1 * c1 - b1 * s1) * sc);
                    st8(blk + (size_t)row * 128 + 64, (a0 * s0 + b0 * c0) * sc, (a1 * s1 + b1 * c1) * sc);
                }
        } else if (dif_u && wc == 0) {
            const int g = x0 >> 4, jj = x0 & 15;
            u16* blk = O + (size_t)(2 * u.pn + g) * PBLK + jj;
            const float* dtab = tab + 2 * 4096 * 64;
#pragma unroll
            for (int ai = 0; ai < 2; ++ai)
#pragma unroll
                for (int m = 0; m < 4; ++m) {
                    const int row = row0 + ai * 128 + m * 16; const float* ct = dtab + (size_t)(row & 4095) * 16 + jj; const float* st = ct + 4096 * 16;
                    const pg8::f32x4 c0 = *(const pg8::f32x4*)ct, c1 = *(const pg8::f32x4*)(ct + 4), s0 = *(const pg8::f32x4*)st, s1 = *(const pg8::f32x4*)(st + 4);
                    const pg8::f32x4 a0 = acc[ai][0][m][0], a1 = acc[ai][0][m][1], b0 = acc[ai][1][m][0], b1 = acc[ai][1][m][1];
                    st8(blk + (size_t)row * 128, a0 * c0 - b0 * s0, a1 * c1 - b1 * s1);
                    st8(blk + (size_t)row * 128 + 16, a0 * s0 + b0 * c0, a1 * s1 + b1 * c1);
                }
        } else {
#pragma unroll
            for (int bj = 0; bj < 2; ++bj) {
                int blkid = 2 * u.pn + bj, col = x0;
                if (dif_u) { const int g = x0 >= 80; blkid = 2 * u.pn + g; col = (bj == 0) ? (g ? x0 - 48 : x0) : (g ? x0 : x0 + 48); }
                u16* blk = O + (size_t)blkid * PBLK + col;
#pragma unroll
                for (int ai = 0; ai < 2; ++ai)
#pragma unroll
                    for (int m = 0; m < 4; ++m) st8(blk + (size_t)(row0 + ai * 128 + m * 16) * 128, acc[ai][bj][m][0], acc[ai][bj][m][1]);
            }
        }
    }
};
struct EpiResid {
    static constexpr bool PERM = false, AFTER_DRAIN = false;
    const float* Zp; const float* pst; const float* pg; const float* pb; float* Z; float alpha, s;
    __device__ __forceinline__ void operator()(const pg8::f32x4 (&acc)[2][2][4][2], const pg8::Unit& u, int wr, int wc, int fr, int fq) const {
        const int row0 = u.pm * 256 + wr * 64 + fr, col0 = u.pn * 256 + wc * 32 + 4 * fq;
#pragma unroll
        for (int ai = 0; ai < 2; ++ai)
#pragma unroll
            for (int m = 0; m < 4; ++m) {
                const int row = row0 + ai * 128 + m * 16;
                float mean = 0.f, rstd = 1.f; if (pst) row_mr(pst, row, mean, rstd);
                const size_t off = (size_t)row * DM + col0;
#pragma unroll
                for (int bj = 0; bj < 2; ++bj)
#pragma unroll
                    for (int n = 0; n < 2; ++n) {
                        const int co = bj * 128 + n * 16;
                        pg8::f32x4 xv = *(const pg8::f32x4*)(Zp + off + co);
                        if (pst) { const pg8::f32x4 gv = *(const pg8::f32x4*)(pg + col0 + co), bv = *(const pg8::f32x4*)(pb + col0 + co); xv = (xv - mean) * rstd * gv + bv; }
                        const pg8::f32x4 z = xv * alpha + acc[ai][bj][m][n] * s;
                        *(pg8::f32x4*)(Z + off + co) = z;
                    }
            }
    }
};
template <class Epi>
__device__ __forceinline__ void run_gemm(unsigned char* lds, const u16* A, const u16* Bt, int M, int N, int K, const Epi& E) {
    pg8::Gemm g; g.A = A; g.Bt = Bt; g.M = M; g.N = N; g.K = K;
    pg8::StaticOrder S; S.init(M, N, opq_gdim(), opq_bid());
    pg8::gemm_phase<Epi, pg8::StaticOrder, false>((PG8_LAS unsigned char*)lds, g, S, E, nullptr);
}

template <bool GATES, bool FINAL>
__device__ __forceinline__ void phase_ln(const float* __restrict__ Z, const float* __restrict__ g, const float* __restrict__ b, float* __restrict__ X, u16* __restrict__ xb, float* __restrict__ st,
                         const float* __restrict__ w_in_l, const float* __restrict__ gate_b, float* __restrict__ gates, float* ldsf) {
    const int tid = opq_tid(), wid = tid >> 6, lane = tid & 63;
    if (GATES) {
        __syncthreads();
        float gw[32];
#pragma unroll
        for (int e = 0; e < 32; ++e) { const int i = tid + NTHR * e; gw[e] = w_in_l[(size_t)(i >> 3) * PW + NPJ + (i & 7)]; }
#pragma unroll
        for (int e = 0; e < 32; ++e) { const int i = tid + NTHR * e; ldsf[(i & 7) * 2048 + (i >> 3)] = gw[e]; }
        __syncthreads();
    }
    for (int row0 = (opq_bid() * 8 + wid) * 2; row0 < T_; row0 += opq_gdim() * 16) {
        f32x4_t v[2][8];
#pragma unroll
        for (int rr = 0; rr < 2; ++rr)
#pragma unroll
            for (int i = 0; i < 8; ++i) v[rr][i] = *(const f32x4_t*)(Z + (size_t)(row0 + rr) * DM + 4 * (lane + 64 * i));
#pragma unroll
        for (int rr = 0; rr < 2; ++rr) {
            const int row = row0 + rr;
            float sm = 0.f;
#pragma unroll
            for (int i = 0; i < 8; ++i) sm += (v[rr][i][0] + v[rr][i][1]) + (v[rr][i][2] + v[rr][i][3]);
            const float mean = wave_sum(sm, lane) * (1.0f / 2048.0f);
            float qq = 0.f;
#pragma unroll
            for (int i = 0; i < 8; ++i) { const f32x4_t a = v[rr][i] - mean; qq += (a[0] * a[0] + a[1] * a[1]) + (a[2] * a[2] + a[3] * a[3]); }
            const float rstd = __builtin_amdgcn_rsqf(wave_sum(qq, lane) * (1.0f / 2048.0f) + 1e-5f);
            if (!FINAL && lane == 0) *(float2*)(st + (size_t)row * 2) = make_float2(mean, rstd);
#pragma unroll
            for (int i = 0; i < 8; ++i) {
                const int c4 = lane + 64 * i;
                const f32x4_t gv = *(const f32x4_t*)(g + 4 * c4), bv = *(const f32x4_t*)(b + 4 * c4);
                const f32x4_t y = (v[rr][i] - mean) * rstd * gv + bv;
                if (FINAL) *(f32x4_t*)(X + (size_t)row * DM + 4 * c4) = y;
                else { uint2 w; w.x = pk2(y[0], y[1]); w.y = pk2(y[2], y[3]); *(uint2*)(xb + (size_t)row * DM + 4 * c4) = w; }
                v[rr][i] = y;
            }
        }
        if (GATES) {
#pragma unroll 1
            for (int j = 0; j < 8; ++j) {
                float a0 = 0.f, a1 = 0.f;
#pragma unroll
                for (int i = 0; i < 8; ++i) { const f32x4_t wv = *(const f32x4_t*)(ldsf + j * 2048 + 4 * (lane + 64 * i)); const f32x4_t p0 = v[0][i] * wv, p1 = v[1][i] * wv; a0 += (p0[0] + p0[1]) + (p0[2] + p0[3]); a1 += (p1[0] + p1[1]) + (p1[2] + p1[3]); }
                a0 = wave_sum(a0, lane); a1 = wave_sum(a1, lane);
                if (lane == 0) { gates[(size_t)row0 * 8 + j] = a0 + gate_b[j]; gates[(size_t)(row0 + 1) * 8 + j] = a1 + gate_b[j]; }
            }
        }
    }
}

__device__ __forceinline__ void rot8c(u16* pa, u16* pb, u32x4_t a, u32x4_t b, f32x4_t c0, f32x4_t c1, f32x4_t s0, f32x4_t s1, float sc) {
    u32x4_t oa, ob;
#pragma unroll
    for (int k = 0; k < 4; ++k) {
        const float t1l = bf2f((u16)(a[k] & 0xffff)), t1h = bf2f((u16)(a[k] >> 16)), t2l = bf2f((u16)(b[k] & 0xffff)), t2h = bf2f((u16)(b[k] >> 16));
        const float cl = k < 2 ? c0[2 * k] : c1[2 * k - 4], ch = k < 2 ? c0[2 * k + 1] : c1[2 * k - 3], sl = k < 2 ? s0[2 * k] : s1[2 * k - 4], sh = k < 2 ? s0[2 * k + 1] : s1[2 * k - 3];
        oa[k] = pk2((t1l * cl - t2l * sl) * sc, (t1h * ch - t2h * sh) * sc);
        ob[k] = pk2((t1l * sl + t2l * cl) * sc, (t1h * sh + t2h * ch) * sc);
    }
    *(u32x4_t*)pa = oa; *(u32x4_t*)pb = ob;
}
template <int NI_SHIFT, int DP, int TW>
__device__ __forceinline__ void rot_sweep(u16* proj, const float* ctab, const float* stab, int mode) {
    const int gtid = opq_bid() * NTHR + opq_tid(), gn = opq_gdim() * NTHR;
    const float KS = 0.08838834764831845f;
    for (int i0 = gtid; i0 < (T_ << NI_SHIFT); i0 += 4 * gn) {
        u16* pp[4]; u32x4_t a[4], b[4]; f32x4_t c0[4], c1[4], s0[4], s1[4]; float sc[4]; bool ok[4];
#pragma unroll
        for (int e = 0; e < 4; ++e) {
            const int i = i0 + e * gn; ok[e] = i < (T_ << NI_SHIFT);
            const int t = ok[e] ? i >> NI_SHIFT : 0, r = i & ((1 << NI_SHIFT) - 1), s = t & 4095;
            int blk, j0;
            if (mode == 0) { const int qk = r >> 5, h = (r >> 3) & 3; j0 = (r & 7) * 8; blk = qk * 4 + h; sc[e] = qk ? KS : 1.0f; }
            else { const int grp = r >> 1; j0 = (r & 1) * 8; blk = 16 + grp; sc[e] = 1.0f; }
            pp[e] = proj + (size_t)blk * PBLK + (size_t)t * 128 + j0;
            a[e] = *(const u32x4_t*)pp[e]; b[e] = *(const u32x4_t*)(pp[e] + DP);
            const float* ct = ctab + s * TW + j0; const float* st = stab + s * TW + j0;
            c0[e] = *(const f32x4_t*)ct; c1[e] = *(const f32x4_t*)(ct + 4); s0[e] = *(const f32x4_t*)st; s1[e] = *(const f32x4_t*)(st + 4);
        }
#pragma unroll
        for (int e = 0; e < 4; ++e) if (ok[e]) rot8c(pp[e], pp[e] + DP, a[e], b[e], c0[e], c1[e], s0[e], s1[e], sc[e]);
    }
}
__device__ __forceinline__ void phase_prep(const Params& p, int l) {
    const int gtid = opq_bid() * NTHR + opq_tid(), gn = opq_gdim() * NTHR;
    u16* proj = (u16*)(p.ws + OFF_HP); u16* mqk = (u16*)(p.ws + OFF_MQK);
    const float* retc = (const float*)(p.ws + OFF_TAB); const float* rets = retc + 4096 * 64; const float* difc = rets + 4096 * 64; const float* difs = difc + 4096 * 16;
    const float KS = 0.08838834764831845f;
    const float* cw = p.in[9] + (size_t)l * 4 * 1024; const float* cb = p.in[10] + (size_t)l * 1024;
    const int c0 = (gtid & 127) * 8;
    f32x4_t w[4][2], bb[2];
#pragma unroll
    for (int j = 0; j < 4; ++j) { w[j][0] = *(const f32x4_t*)(cw + j * 1024 + c0); w[j][1] = *(const f32x4_t*)(cw + j * 1024 + c0 + 4); }
    bb[0] = *(const f32x4_t*)(cb + c0); bb[1] = *(const f32x4_t*)(cb + c0 + 4);
    const u16* src = proj + (size_t)(40 + (c0 >> 7)) * PBLK + (c0 & 127);
    u16* dst = mqk + (size_t)(c0 >> 7) * PBLK + (c0 & 127);
    const float sck = c0 >= 512 ? KS : 1.0f;
    for (int i0 = gtid; i0 < T_ * 128; i0 += 4 * gn) {
        u32x4_t x[4][4];
#pragma unroll
        for (int e = 0; e < 4; ++e) {
            const int i = i0 + e * gn, t = i < T_ * 128 ? i >> 7 : 0, s = t & 4095;
#pragma unroll
            for (int j = 0; j < 4; ++j) x[e][j] = (s - 3 + j >= 0) ? *(const u32x4_t*)(src + (size_t)(t - 3 + j) * 128) : (u32x4_t){0u, 0u, 0u, 0u};
        }
#pragma unroll
        for (int e = 0; e < 4; ++e) {
            const int i = i0 + e * gn;
            if (i < T_ * 128) {
                const int t = i >> 7;
                f32x4_t y0 = bb[0], y1 = bb[1];
#pragma unroll
                for (int j = 0; j < 4; ++j) {
                    const u32x4_t xv = x[e][j];
                    const f32x4_t lo = {bf2f((u16)(xv[0] & 0xffff)), bf2f((u16)(xv[0] >> 16)), bf2f((u16)(xv[1] & 0xffff)), bf2f((u16)(xv[1] >> 16))};
                    const f32x4_t hi = {bf2f((u16)(xv[2] & 0xffff)), bf2f((u16)(xv[2] >> 16)), bf2f((u16)(xv[3] & 0xffff)), bf2f((u16)(xv[3] >> 16))};
                    y0 += w[j][0] * lo; y1 += w[j][1] * hi;
                }
                u32x4_t o;
                o[0] = pk2(silu_f(y0[0]) * sck, silu_f(y0[1]) * sck); o[1] = pk2(silu_f(y0[2]) * sck, silu_f(y0[3]) * sck);
                o[2] = pk2(silu_f(y1[0]) * sck, silu_f(y1[1]) * sck); o[3] = pk2(silu_f(y1[2]) * sck, silu_f(y1[3]) * sck);
                *(u32x4_t*)(dst + (size_t)t * 128) = o;
            }
        }
    }
}

__device__ __forceinline__ da::BlockRef<__hip_bfloat16, float> diff_ref(int inst, int qb, const __hip_bfloat16* proj, float* Od) {
    const int b = inst >> 4, h = (inst >> 2) & 3, m = (inst >> 1) & 1, e = inst & 1;
    da::BlockRef<__hip_bfloat16, float> r;
    r.Q = proj + (size_t)(16 + 2 * h + m) * PBLK + (size_t)(b * 4096 + qb * 256) * 128;
    r.K = proj + (size_t)(24 + 2 * h + m) * PBLK + (size_t)(b * 4096) * 128;
    r.V = proj + (size_t)(32 + 2 * h + e) * PBLK + (size_t)(b * 4096) * 128;
    r.O = Od + (size_t)(b * 4096 + qb * 256) * DM + h * 512 + m * 256 + e * 128;
    r.P0 = qb * 256;
    return r;
}
__device__ __forceinline__ void phase_diffattn(const Params& p, unsigned char* lds) {
    typedef __hip_bfloat16 TI;
    const TI* proj = (const TI*)(p.ws + OFF_HP); float* Od = p.out;
    const int total = 512, stride = opq_gdim();
    const int Wrt = 4096 + (p.ws == nullptr ? 64 : 0), SKVrt = 4096 + (p.out == nullptr ? 64 : 0);
#define IT_INST(L_) ((((L_) & 7) << 3) + ((L_) >> 6))
#define IT_X(L_) (((L_) >> 3) & 7)
    int L = opq_bid(); if (L >= total) return;
    int pass = 0;
    da::BlockRef<TI, float> cur = diff_ref(IT_INST(L), IT_X(L), proj, Od);
    da::Seam<TI> S;
    da::causal_swa_prime<TI, float>(cur, Wrt, (char*)lds, S);
    for (;;) {
        const bool more_pass = pass == 0, more_item = L + stride < total, last = !more_pass && !more_item;
        int passn = pass + 1, Ln = L;
        if (!more_pass) { passn = 0; Ln = more_item ? L + stride : L; }
        const int qbn = passn ? 15 - IT_X(Ln) : IT_X(Ln);
        const da::BlockRef<TI, float> nxt = last ? cur : diff_ref(IT_INST(Ln), qbn, proj, Od);
        da::causal_swa_block<TI, float>(cur, nxt, SKVrt, Wrt, (char*)lds, S);
        if (last) break;
        cur = nxt; pass = passn; L = Ln;
    }
}
__device__ __forceinline__ void phase_diffcomb(const Params& p, int l) {
    const int tid = opq_tid(), wid = tid >> 6, lane = tid & 63;
    const float* Od = p.out; u16* mixed = (u16*)(p.ws + OFF_MIX);
    const float* dl = p.in[7] + (size_t)l * 512; const float* g = p.in[8] + (size_t)l * 256;
    const float lam_init = 0.8f - 0.6f * __expf(-0.3f * (float)l);
    const float s1 = wave_sum(dl[lane] * dl[128 + lane] + dl[64 + lane] * dl[192 + lane], lane);
    const float s2 = wave_sum(dl[256 + lane] * dl[384 + lane] + dl[320 + lane] * dl[448 + lane], lane);
    const float lam = __expf(s1) - __expf(s2) + lam_init;
    const float4 gv = ((const float4*)g)[lane];
    const float post = 1.0f - lam_init;
    for (int u0 = (opq_bid() * 8 + wid) * 4; u0 < T_ * 4; u0 += opq_gdim() * 32) {
        float4 a0[4], a1[4];
#pragma unroll
        for (int k = 0; k < 4; ++k) { const float4* o0 = (const float4*)(Od + (size_t)(u0 >> 2) * DM + k * 512); a0[k] = o0[lane]; a1[k] = o0[64 + lane]; }
#pragma unroll
        for (int k = 0; k < 4; ++k) {
            float4 v; v.x = a0[k].x - lam * a1[k].x; v.y = a0[k].y - lam * a1[k].y; v.z = a0[k].z - lam * a1[k].z; v.w = a0[k].w - lam * a1[k].w;
            const float ss = wave_sum((v.x * v.x + v.y * v.y) + (v.z * v.z + v.w * v.w), lane);
            const float rms = __builtin_amdgcn_rsqf(ss * (1.0f / 256.0f) + 1e-6f) * post;
            uint2 w; w.x = pk2(v.x * rms * gv.x, v.y * rms * gv.y); w.y = pk2(v.z * rms * gv.z, v.w * rms * gv.w);
            *(uint2*)(mixed + (size_t)(u0 >> 2) * DM + 512 + k * 256 + 4 * lane) = w;
        }
    }
}

__device__ __forceinline__ bf16x8_t frag(const u16* tile, int row0, int k0, int lane) {
    return *(const bf16x8_t*)(tile + (row0 + (lane & 15)) * LDT + k0 + 8 * (lane >> 4));
}
#define TILE_LOAD(rg, TR, src, ld) do { _Pragma("unroll") for (int k_ = 0; k_ < L / 32; ++k_) { const int i_ = tid + NTHR * k_; \
        const int r_ = (TR) ? (((i_ % L) + rot) & (L - 1)) : (((i_ >> 4) + rot) & (L - 1)), c_ = (TR) ? (i_ / L) * 8 : (i_ & 15) * 8; \
        rg[k_] = *(const u32x4_t*)((src) + (size_t)r_ * (ld) + c_); } } while (0)
#define TILE_STORE_ROWS(dst, rg) do { _Pragma("unroll") for (int k_ = 0; k_ < L / 32; ++k_) { const int i_ = tid + NTHR * k_, r_ = ((i_ >> 4) + rot) & (L - 1), c_ = (i_ & 15) * 8; \
        *(u32x4_t*)((dst) + r_ * LDT + c_) = rg[k_]; } } while (0)
__device__ __forceinline__ void store_T8(u16* dst, int c8, int r, u32x4_t v, const float* rowscale) {
    const float sc = rowscale ? rowscale[r] : 1.0f;
#pragma unroll
    for (int q = 0; q < 4; ++q) {
        u16 lo = (u16)(v[q] & 0xffff), hi = (u16)(v[q] >> 16);
        if (rowscale) { lo = f2bf(bf2f(lo) * sc); hi = f2bf(bf2f(hi) * sc); }
        dst[(c8 + 2 * q) * LDT + r] = lo; dst[(c8 + 2 * q + 1) * LDT + r] = hi;
    }
}
#define TILE_STORE_T(dst, rg, rowscale) do { _Pragma("unroll") for (int k_ = 0; k_ < L / 32; ++k_) { const int i_ = tid + NTHR * k_, r_ = ((i_ % L) + rot) & (L - 1), c_ = (i_ / L) * 8; \
        store_T8((dst), c_, r_, rg[k_], (rowscale)); } } while (0)
template <int TYPE>
__device__ __forceinline__ void chunk_l1(const Params& p, unsigned char* lds) {
    constexpr int L = TYPE ? 64 : 128, NC = 4096 / L, NIT = 16 * NC;
    const int tid = opq_tid(), wid = tid >> 6, lane = tid & 63;
    u16* sK = (u16*)lds; u16* sV = sK + 128 * LDT; float* sW = (float*)(lds + 2 * 128 * LDT * 2);
    const u16* proj = (const u16*)(p.ws + OFF_HP); const u16* mqk = (const u16*)(p.ws + OFF_MQK); const float* gates = (const float*)(p.ws + OFF_GATE);
    float* ST = (float*)(p.ws + (TYPE ? OFF_STM : OFF_STR)); float* nm = (float*)(p.ws + OFF_NM); float* scb = (float*)(p.ws + OFF_SC);
    for (int it = opq_bid(); it < NIT; it += opq_gdim()) {
        const int bh = it / NC, c = it % NC, b = bh >> 2, h = bh & 3; const size_t t0 = (size_t)b * 4096 + (size_t)c * L;
        const int rot = (opq_bid() * 29) & (L - 1);
        u32x4_t rk[L / 32], rv[L / 32];
        if (TYPE == 0) { TILE_LOAD(rk, true, proj + (size_t)(4 + h) * PBLK + t0 * 128, 128); TILE_LOAD(rv, true, proj + (size_t)(8 + h) * PBLK + t0 * 128, 128); }
        else           { TILE_LOAD(rk, true, mqk + (size_t)(4 + h) * PBLK + t0 * 128, 128); TILE_LOAD(rv, true, proj + (size_t)(48 + h) * PBLK + t0 * 128, 128); }
        float fp = 0.f, ip = 0.f;
        if (TYPE == 1 && wid == 0) { fp = gates[(t0 + lane) * 8 + 4 + h]; ip = gates[(t0 + lane) * 8 + h]; }
        __syncthreads();
        if (TYPE == 0) { if (tid < 128) { const float lg = ret_logg(h); sW[tid] = __expf((float)(127 - tid) * lg); } }
        else if (wid == 0) {
            const float bb = scan_sum(logsig_f(fp), lane), bL = __int_as_float(__builtin_amdgcn_readlane(__float_as_int(bb), 63)), wl = bL - bb + ip, wmax = wave_max(wl, lane);
            sW[lane] = __expf(wl - wmax);
            if (lane == 0) { scb[(bh * 64 + c) * 4 + 0] = bL; scb[(bh * 64 + c) * 4 + 1] = wmax; }
        }
        __syncthreads();
        TILE_STORE_T(sK, rk, sW); TILE_STORE_T(sV, rv, (const float*)nullptr);
        __syncthreads();
        f32x4_t acc[8];
#pragma unroll
        for (int ct = 0; ct < 8; ++ct) acc[ct] = (f32x4_t){0.f, 0.f, 0.f, 0.f};
        for (int j0 = 0; j0 < L; j0 += 32) {
            const bf16x8_t a = frag(sK, 16 * wid, j0, lane);
#pragma unroll
            for (int ct = 0; ct < 8; ++ct) { const bf16x8_t bb = frag(sV, 16 * ct, j0, lane); acc[ct] = __builtin_amdgcn_mfma_f32_16x16x32_bf16(a, bb, acc[ct], 0, 0, 0); }
        }
        float* dst = ST + (size_t)(bh * NC + c) * 16384;
#pragma unroll
        for (int ct = 0; ct < 8; ++ct)
#pragma unroll
            for (int r = 0; r < 4; ++r) dst[(16 * wid + 4 * (lane >> 4) + r) * 128 + 16 * ct + (lane & 15)] = acc[ct][r];
        if (TYPE == 1 && tid < 128) { float s = 0.f; for (int j = 0; j < L; ++j) s += bf2f(sK[tid * LDT + j]); nm[(size_t)(bh * 64 + c) * 128 + tid] = s; }
    }
}
__device__ __forceinline__ void chunk_scan(const Params& p) {
    const int gtid = opq_bid() * NTHR + opq_tid(), gn = opq_gdim() * NTHR;
    float* str = (float*)(p.ws + OFF_STR); float* stm = (float*)(p.ws + OFF_STM); float* nm = (float*)(p.ws + OFF_NM); float* scb = (float*)(p.ws + OFF_SC);
    for (int u = gtid; u < 2 * 65536 + 2048; u += gn) {
        if (u < 65536) {
            const int bh = u >> 12, e4 = u & 4095, h = bh & 3;
            const float lg = ret_logg(h), dec = __expf(128.0f * lg);
            float4* ptr = (float4*)(str + (size_t)bh * 32 * 16384) + e4; float4 C = make_float4(0.f, 0.f, 0.f, 0.f);
#pragma unroll 16
            for (int c = 0; c < 32; ++c) { const float4 kv = ptr[(size_t)c * 4096]; ptr[(size_t)c * 4096] = C; C.x = dec * C.x + kv.x; C.y = dec * C.y + kv.y; C.z = dec * C.z + kv.z; C.w = dec * C.w + kv.w; }
        } else if (u < 2 * 65536) {
            const int v = u - 65536, bh = v >> 12, e4 = v & 4095;
            float4* ptr = (float4*)(stm + (size_t)bh * 64 * 16384) + e4; const float* sp = scb + bh * 64 * 4; float4 C = make_float4(0.f, 0.f, 0.f, 0.f); float m = 0.f;
#pragma unroll 16
            for (int c = 0; c < 64; ++c) {
                const float bL = sp[c * 4], wmax = sp[c * 4 + 1], mn = fmaxf(bL + m, wmax), dec = __expf(bL + m - mn), sc = __expf(wmax - mn);
                const float4 kv = ptr[(size_t)c * 4096]; ptr[(size_t)c * 4096] = C;
                C.x = dec * C.x + sc * kv.x; C.y = dec * C.y + sc * kv.y; C.z = dec * C.z + sc * kv.z; C.w = dec * C.w + sc * kv.w; m = mn; }
        } else {
            const int v = u - 2 * 65536, bh = v >> 7, e = v & 127;
            float* ptr = nm + (size_t)bh * 64 * 128 + e; float* sp = scb + bh * 64 * 4; float C = 0.f, m = 0.f;
#pragma unroll 8
            for (int c = 0; c < 64; ++c) {
                const float bL = sp[c * 4], wmax = sp[c * 4 + 1], mn = fmaxf(bL + m, wmax), dec = __expf(bL + m - mn), sc = __expf(wmax - mn);
                const float kv = ptr[c * 128]; ptr[c * 128] = C; if (e == 0) sp[c * 4 + 2] = m; C = dec * C + sc * kv; m = mn; }
        }
    }
}
template <int TYPE>
__device__ __forceinline__ void chunk_l3(const Params& p, int l, unsigned char* lds) {
    constexpr int L = TYPE ? 64 : 128, NC = 4096 / L, NIT = 16 * NC, NRT = L / 16, WPR = 8 / NRT, NCT = 8 / WPR;
    const int tid = opq_tid(), wid = tid >> 6, lane = tid & 63;
    u16* sQ = (u16*)lds; u16* sK = sQ + 128 * LDT; u16* sV = sK + 128 * LDT; u16* sC = sV + 128 * LDT;
    float* sF = (float*)(lds + 4 * 128 * LDT * 2);
    float* rowoff = sF, * uvec = sF + 128, * inter = sF + 256, * emt = sF + 384, * den = sF + 512, * qn = sF + 640, * nst = sF + 768;
    float* sH = (float*)lds;
    const u16* proj = (const u16*)(p.ws + OFF_HP); const u16* mqk = (const u16*)(p.ws + OFF_MQK); const float* gates = (const float*)(p.ws + OFF_GATE);
    const float* ST = (const float*)(p.ws + (TYPE ? OFF_STM : OFF_STR)); const float* nm = (const float*)(p.ws + OFF_NM); const float* scb = (const float*)(p.ws + OFF_SC);
    u16* mixed = (u16*)(p.ws + OFF_MIX);
    const float* ng = TYPE ? (p.in[12] + (size_t)l * 512) : (p.in[6] + (size_t)l * 512);
    for (int it = opq_bid(); it < NIT; it += opq_gdim()) {
        const int bh = it / NC, c = it % NC, b = bh >> 2, h = bh & 3; const size_t t0 = (size_t)b * 4096 + (size_t)c * L;
        const int rot = (opq_bid() * 29) & (L - 1);
        u32x4_t rq[L / 32], rk[L / 32], rv[L / 32]; f32x4_t rc[8];
        if (TYPE == 0) { TILE_LOAD(rq, false, proj + (size_t)h * PBLK + t0 * 128, 128); TILE_LOAD(rk, false, proj + (size_t)(4 + h) * PBLK + t0 * 128, 128); TILE_LOAD(rv, true, proj + (size_t)(8 + h) * PBLK + t0 * 128, 128); }
        else           { TILE_LOAD(rq, false, mqk + (size_t)h * PBLK + t0 * 128, 128); TILE_LOAD(rk, false, mqk + (size_t)(4 + h) * PBLK + t0 * 128, 128); TILE_LOAD(rv, true, proj + (size_t)(48 + h) * PBLK + t0 * 128, 128); }
        {
            const float4* Cg = (const float4*)(ST + (size_t)(bh * NC + c) * 16384);
#pragma unroll
            for (int k = 0; k < 8; ++k) { const int i = tid + NTHR * k, d = ((i & 127) + 3 * rot) & 127, v0 = (((i >> 7) + rot) & 31) * 4; rc[k] = *(const f32x4_t*)(Cg + d * 32 + (v0 >> 2)); }
        }
        float fp = 0.f, ip = 0.f, m_in = 0.f, nld = 0.f;
        if (TYPE == 1) {
            if (wid == 0) { fp = gates[(t0 + lane) * 8 + 4 + h]; ip = gates[(t0 + lane) * 8 + h]; m_in = scb[(bh * 64 + c) * 4 + 2]; }
            if (tid >= 128 && tid < 256) nld = nm[(size_t)(bh * 64 + c) * 128 + tid - 128];
        }
        __syncthreads();
        TILE_STORE_ROWS(sQ, rq); TILE_STORE_ROWS(sK, rk); TILE_STORE_T(sV, rv, (const float*)nullptr);
#pragma unroll
        for (int k = 0; k < 8; ++k) { const int i = tid + NTHR * k, d = ((i & 127) + 3 * rot) & 127, v0 = (((i >> 7) + rot) & 31) * 4;
            sC[(v0 + 0) * LDT + d] = f2bf(rc[k][0]); sC[(v0 + 1) * LDT + d] = f2bf(rc[k][1]); sC[(v0 + 2) * LDT + d] = f2bf(rc[k][2]); sC[(v0 + 3) * LDT + d] = f2bf(rc[k][3]); }
        if (TYPE == 0) {
            if (tid < 128) { const float lg = ret_logg(h), bi = (float)(tid + 1) * lg; rowoff[tid] = bi; uvec[tid] = -bi; inter[tid] = __expf(bi); emt[tid] = 1.0f; }
        } else {
            if (wid == 0) {
                const float bb = scan_sum(logsig_f(fp), lane), uu = ip - bb, pm = scan_max(uu, lane);
                const float mt = bb + fmaxf(m_in, pm);
                rowoff[lane] = bb - mt; uvec[lane] = uu; inter[lane] = __expf(bb + m_in - mt); emt[lane] = __expf(-mt);
            }
            if (tid >= 128 && tid < 256) nst[tid - 128] = nld;
        }
        __syncthreads();
        unsigned gpre[L / 8];
#pragma unroll
        for (int k = 0; k < L / 8; ++k) gpre[k] = *(const unsigned*)(proj + (size_t)((TYPE ? 52 : 12) + h) * PBLK + (t0 + wid + 8 * k) * 128 + 2 * lane);
        f32x4_t sacc[NRT];
        if (wid < NRT) {
#pragma unroll
            for (int ct = 0; ct < NRT; ++ct) sacc[ct] = (f32x4_t){0.f, 0.f, 0.f, 0.f};
            for (int d0 = 0; d0 < 128; d0 += 32) {
                const bf16x8_t a = frag(sQ, 16 * wid, d0, lane);
#pragma unroll
                for (int ct = 0; ct < NRT; ++ct) { const bf16x8_t bb = frag(sK, 16 * ct, d0, lane); sacc[ct] = __builtin_amdgcn_mfma_f32_16x16x32_bf16(a, bb, sacc[ct], 0, 0, 0); }
            }
        }
        if (TYPE == 1) {
            for (int i = wid; i < L; i += 8) { float s = bf2f(sQ[i * LDT + lane]) * nst[lane] + bf2f(sQ[i * LDT + 64 + lane]) * nst[64 + lane]; s = wave_sum(s, lane); if (lane == 0) qn[i] = s; }
        }
        __syncthreads();
        u16* sP = sK;
        if (wid < NRT) {
#pragma unroll
            for (int r = 0; r < 4; ++r) {
                const int i = 16 * wid + 4 * (lane >> 4) + r; const float ro = rowoff[i]; float rs = 0.f;
#pragma unroll
                for (int ct = 0; ct < NRT; ++ct) { const int j = 16 * ct + (lane & 15); const float pv = (j <= i) ? sacc[ct][r] * __expf(ro + uvec[j]) : 0.f; rs += pv; sP[i * LDT + j] = f2bf(pv); }
                rs += shx(rs, 1, lane); rs += shx(rs, 2, lane); rs += shx(rs, 4, lane); rs += shx(rs, 8, lane);
                if ((lane & 15) == 0) den[i] = rs;
            }
        }
        __syncthreads();
        const int rt = wid % NRT, ctb = (wid / NRT) * NCT;
        f32x4_t acc[NCT];
#pragma unroll
        for (int ct = 0; ct < NCT; ++ct) acc[ct] = (f32x4_t){0.f, 0.f, 0.f, 0.f};
        for (int d0 = 0; d0 < 128; d0 += 32) {
            const bf16x8_t a = frag(sQ, 16 * rt, d0, lane);
#pragma unroll
            for (int ct = 0; ct < NCT; ++ct) { const bf16x8_t bb = frag(sC, 16 * (ctb + ct), d0, lane); acc[ct] = __builtin_amdgcn_mfma_f32_16x16x32_bf16(a, bb, acc[ct], 0, 0, 0); }
        }
#pragma unroll
        for (int r = 0; r < 4; ++r) { const float sc = inter[16 * rt + 4 * (lane >> 4) + r];
#pragma unroll
            for (int ct = 0; ct < NCT; ++ct) acc[ct][r] *= sc; }
        for (int j0 = 0; j0 < L; j0 += 32) {
            const bf16x8_t a = frag(sP, 16 * rt, j0, lane);
#pragma unroll
            for (int ct = 0; ct < NCT; ++ct) { const bf16x8_t bb = frag(sV, 16 * (ctb + ct), j0, lane); acc[ct] = __builtin_amdgcn_mfma_f32_16x16x32_bf16(a, bb, acc[ct], 0, 0, 0); }
        }
        __syncthreads();
#pragma unroll
        for (int ct = 0; ct < NCT; ++ct)
#pragma unroll
            for (int r = 0; r < 4; ++r) sH[(16 * rt + 4 * (lane >> 4) + r) * 129 + 16 * (ctb + ct) + (lane & 15)] = acc[ct][r];
        __syncthreads();
        const float g0 = ng[h * 128 + 2 * lane], g1 = ng[h * 128 + 2 * lane + 1];
#pragma unroll
        for (int k = 0; k < L / 8; ++k) {
            const int i = wid + 8 * k; const size_t t = t0 + i;
            float h0 = sH[i * 129 + 2 * lane], h1 = sH[i * 129 + 2 * lane + 1];
            const float ga = bf2f((u16)(gpre[k] & 0xffff)), gb = bf2f((u16)(gpre[k] >> 16));
            if (TYPE == 1) {
                const float dn = den[i] + inter[i] * qn[i], dd = fmaxf(fabsf(dn), emt[i]);
                const float rdd = __builtin_amdgcn_rcpf(dd); h0 = h0 * rdd * sigmoid_f(ga); h1 = h1 * rdd * sigmoid_f(gb);
            }
            const float mean = wave_sum(h0 + h1, lane) * (1.0f / 128.0f), d0 = h0 - mean, d1 = h1 - mean;
            const float var = wave_sum(d0 * d0 + d1 * d1, lane) * (1.0f / 128.0f), rstd = __builtin_amdgcn_rsqf(var + 1e-6f);
            float y0 = d0 * rstd * g0, y1 = d1 * rstd * g1;
            int col;
            if (TYPE == 0) { y0 *= silu_f(ga); y1 *= silu_f(gb); col = h * 128 + 2 * lane; } else col = 1536 + h * 128 + 2 * lane;
            *(unsigned*)(mixed + t * DM + col) = pk2(y0, y1);
        }
    }
}

__device__ __forceinline__ Params load_params() {
    Params r{};
#if defined(__HIP_DEVICE_COMPILE__)
    const __attribute__((address_space(4))) Params* k = (const __attribute__((address_space(4))) Params*)__builtin_amdgcn_kernarg_segment_ptr();
    asm volatile("" : "+s"(k));
#pragma unroll
    for (int i = 0; i < 16; ++i) r.in[i] = k->in[i];
    r.out = k->out; r.ws = k->ws;
#endif
    return r;
}
#define PWS(off) (q.ws + (off))
#define GSYNC() do { const Params q_ = load_params(); XcdBarrier b_; b_.bar = (unsigned*)(q_.ws + OFF_BAR); b_.x = xb_xcc_id(); b_.st = (volatile LAS unsigned*)((LAS unsigned char*)lds + LDS_PHASE); xcd_barrier(b_); } while (0)
#ifndef PHMASK
#define PHMASK 0xFFFF
#endif
__global__ void __launch_bounds__(NTHR, 2) fwd_megakernel(Params p_unused) {
    extern __shared__ __attribute__((aligned(16))) unsigned char lds[];
    cg::grid_group grid = cg::this_grid();
    volatile LAS unsigned* xst = (volatile LAS unsigned*)((LAS unsigned char*)lds + LDS_PHASE);
    if (opq_tid() == 0) { xst[0] = 0u; xst[1] = 0u; }
    __syncthreads();
    { const Params q = load_params(); (void)xcd_barrier_post((unsigned*)PWS(OFF_BAR), xst); }
    const float ALPHA = 1.41421356237309515f;
    { const Params q = load_params(); phase_init(q); }
    grid.sync();
#define STAT(i) ((float*)PWS(OFF_STAT) + (size_t)(i) * T_ * 2)
#define LNG(i) (q.in[1] + (size_t)(i) * DM)
#define LNB(i) (q.in[2] + (size_t)(i) * DM)
#define CSL(off) ((const float*)PWS(OFF_CS) + (size_t)l * CS_LAYER + (off))
#pragma unroll 1
    for (int l = 0; l < 2; ++l) {
        { const Params q = load_params(); phase_weights(q, l, lds); }
        GSYNC();
        { const Params q = load_params(); EpiSwiGLU e; e.H = (u16*)PWS(OFF_HP); run_gemm(lds, (const u16*)PWS(OFF_XB), (const u16*)PWS(OFF_WGU1), T_, NGU, DM, e); }
        GSYNC();
        { const Params q = load_params(); EpiResid e; e.Zp = l ? (const float*)PWS(OFF_Z) : q.in[0]; e.pst = l ? STAT(2) : nullptr; e.pg = LNG(2); e.pb = LNB(2);
          e.Z = (float*)PWS(OFF_Z); e.alpha = opq_f(ALPHA); e.s = opq_f(0.5f); run_gemm(lds, (const u16*)PWS(OFF_HP), (const u16*)PWS(OFF_WD1), T_, DM, DFF, e); }
        GSYNC();
        { const Params q = load_params(); phase_ln<true, false>((const float*)PWS(OFF_Z), LNG(l * 3 + 0), LNB(l * 3 + 0), nullptr, (u16*)PWS(OFF_XB), STAT(l * 3 + 0), q.in[5] + (size_t)l * DM * PW, q.in[11] + (size_t)l * 8, (float*)PWS(OFF_GATE), (float*)lds); }
        GSYNC();
        { const Params q = load_params(); EpiProjBM e; e.O = (u16*)PWS(OFF_HP); e.tab = (const float*)PWS(OFF_TAB); run_gemm(lds, (const u16*)PWS(OFF_XB), (const u16*)PWS(OFF_WIN), T_, NPJ, DM, e); }
        GSYNC();
        { const Params q = load_params(); phase_prep(q, l); }
        GSYNC();
        { const Params q = load_params(); phase_diffattn(q, lds); }
        { const Params q = load_params(); chunk_l1<0>(q, lds); }
        { const Params q = load_params(); chunk_l1<1>(q, lds); }
        GSYNC();
        { const Params q = load_params(); chunk_scan(q); }
        GSYNC();
        { const Params q = load_params(); chunk_l3<0>(q, l, lds); }
        { const Params q = load_params(); chunk_l3<1>(q, l, lds); }
        { const Params q = load_params(); phase_diffcomb(q, l); }
        GSYNC();
        { const Params q = load_params(); EpiResid e; e.Zp = (const float*)PWS(OFF_Z); e.pst = STAT(l * 3 + 0); e.pg = LNG(l * 3 + 0); e.pb = LNB(l * 3 + 0);
          e.Z = (float*)PWS(OFF_Z); e.alpha = opq_f(ALPHA); e.s = opq_f(1.0f); run_gemm(lds, (const u16*)PWS(OFF_MIX), (const u16*)PWS(OFF_WOUT), T_, DM, DM, e); }
        GSYNC();
        { const Params q = load_params(); phase_ln<false, false>((const float*)PWS(OFF_Z), LNG(l * 3 + 1), LNB(l * 3 + 1), nullptr, (u16*)PWS(OFF_XB), STAT(l * 3 + 1), nullptr, nullptr, nullptr, (float*)lds); }
        GSYNC();
        { const Params q = load_params(); EpiSwiGLU e; e.H = (u16*)PWS(OFF_HP); run_gemm(lds, (const u16*)PWS(OFF_XB), (const u16*)PWS(OFF_WGU2), T_, NGU, DM, e); }
        GSYNC();
        { const Params q = load_params(); EpiResid e; e.Zp = (const float*)PWS(OFF_Z); e.pst = STAT(l * 3 + 1); e.pg = LNG(l * 3 + 1); e.pb = LNB(l * 3 + 1);
          e.Z = (float*)PWS(OFF_Z); e.alpha = opq_f(ALPHA); e.s = opq_f(0.5f); run_gemm(lds, (const u16*)PWS(OFF_HP), (const u16*)PWS(OFF_WD2), T_, DM, DFF, e); }
        GSYNC();
        if (l == 0) { const Params q = load_params(); phase_ln<false, false>((const float*)PWS(OFF_Z), LNG(2), LNB(2), nullptr, (u16*)PWS(OFF_XB), STAT(2), nullptr, nullptr, nullptr, (float*)lds); }
        else        { const Params q = load_params(); phase_ln<false, true>((const float*)PWS(OFF_Z), LNG(5), LNB(5), q.out, nullptr, nullptr, nullptr, nullptr, nullptr, (float*)lds); }
        if (l == 0) GSYNC();
    }
}

extern "C" void kernel_launch(void* const* d_in, const int* in_sizes, int n_in, void* d_out, int out_size, void* d_ws, size_t ws_size, hipStream_t stream) {
    static int grid_blocks = 0;
    if (grid_blocks == 0) {
        if (n_in != 16 || out_size != T_ * DM || ws_size < WS_END) { fprintf(stderr, "kernel_launch: unexpected shapes (n_in %d out %d ws %zu need %zu)\n", n_in, out_size, ws_size, (size_t)WS_END); grid_blocks = -1; return; }
        int dev = 0, cus = 0, per_cu = 0;
        (void)hipGetDevice(&dev);
        (void)hipDeviceGetAttribute(&cus, hipDeviceAttributeMultiprocessorCount, dev);
        if (hipFuncSetAttribute((const void*)fwd_megakernel, hipFuncAttributeMaxDynamicSharedMemorySize, LDS_TOTAL) != hipSuccess) fprintf(stderr, "kernel_launch: hipFuncSetAttribute failed\n");
        if (hipOccupancyMaxActiveBlocksPerMultiprocessor(&per_cu, (const void*)fwd_megakernel, NTHR, LDS_TOTAL) != hipSuccess || per_cu < 1) { fprintf(stderr, "kernel_launch: occupancy query gave %d\n", per_cu); per_cu = 1; }
        (void)hipGetLastError();
        if (cus <= 0) cus = 256;
        grid_blocks = cus * per_cu;
    }
    if (grid_blocks < 0) return;
    if (hipMemsetAsync((unsigned char*)d_ws + OFF_BAR, 0, SZ_BAR, stream) != hipSuccess) { fprintf(stderr, "kernel_launch: memset of the barrier words failed\n"); return; }
    Params p{};
    for (int i = 0; i < 16; ++i) p.in[i] = (const float*)d_in[i];
    p.out = (float*)d_out; p.ws = (unsigned char*)d_ws;
    void* args[] = {&p};
    hipError_t e = hipLaunchCooperativeKernel((const void*)fwd_megakernel, dim3(grid_blocks), dim3(NTHR), args, LDS_TOTAL, stream);
    if (e != hipSuccess) fprintf(stderr, "kernel_launch: cooperative launch failed: %s (grid %d)\n", hipGetErrorString(e), grid_blocks);
}
```

```cpp
#include <hip/hip_runtime.h>
#include <hip/hip_bf16.h>
#include <hip/hip_cooperative_groups.h>
#include <cstdio>
#include <cstdint>
namespace cg = cooperative_groups;
__device__ __forceinline__ int opq_tid() { int t = (int)threadIdx.x; asm volatile("" : "+v"(t)); return t; }
__device__ __forceinline__ int opq_bid() { int t = (int)blockIdx.x; asm volatile("" : "+s"(t)); return t; }
__device__ __forceinline__ int opq_gdim() { int t = (int)gridDim.x; asm volatile("" : "+s"(t)); return t; }
__device__ __forceinline__ float opq_f(float x) { asm volatile("" : "+v"(x)); return x; }

#define XB_TMO      128
#define XB_XCNT(j)  (256  + 64 * (j))
#define XB_XSUB(j)  (1280 + 64 * (j))
#define XB_XGEN(j)  (2304 + 64 * (j))
#define XB_TOP      3328
#define XB_TOPGEN   3392
#define XCD_BAR_WORDS 3456
#define XB_SPIN_CAP (1u << 18)
#define LAS __attribute__((address_space(3)))

__device__ __forceinline__ unsigned xb_ld(unsigned* p)              { return __hip_atomic_load(p, __ATOMIC_RELAXED, __HIP_MEMORY_SCOPE_AGENT); }
__device__ __forceinline__ unsigned xb_add(unsigned* p, unsigned v) { return __hip_atomic_fetch_add(p, v, __ATOMIC_RELAXED, __HIP_MEMORY_SCOPE_AGENT); }
__device__ __forceinline__ unsigned xb_xcc_id() { return (unsigned)__builtin_amdgcn_s_getreg((3 << 11) | 20) & 0xFu; }
#define XB_SPIN(cond, bar) do { unsigned _sp = 0; while (cond) { __builtin_amdgcn_s_sleep(1); \
    if ((++_sp & 255u) == 0u) { if (xb_ld(&(bar)[XB_TMO])) break; if (_sp > XB_SPIN_CAP) { atomicAdd(&(bar)[XB_TMO], 1u); break; } } } } while (0)

struct XcdBarrier {
    unsigned* bar; unsigned x;
    volatile LAS unsigned* st;
};

__device__ __forceinline__ XcdBarrier xcd_barrier_post(unsigned* bar, volatile LAS unsigned* st) {
    XcdBarrier b; b.bar = bar; b.x = xb_xcc_id(); b.st = st;
    if (opq_tid() == 0) (void)xb_add(&bar[XB_XCNT(b.x)], 1u);
    return b;
}
__device__ __forceinline__ void xcd_barrier_complete(unsigned* bar, unsigned x, unsigned& nloc, unsigned& nx) {
    const unsigned G = (unsigned)opq_gdim();
    unsigned sum, cnt, mine, sp = 0u;
    for (;;) {
        sum = 0u; cnt = 0u; mine = 0u;
#pragma unroll
        for (unsigned j = 0; j < 16; ++j) { const unsigned c = xb_ld(&bar[XB_XCNT(j)]); sum += c; cnt += (c > 0u) ? 1u : 0u; mine = (j == x) ? c : mine; }
        if (sum == G) break;
        __builtin_amdgcn_s_sleep(1);
        if ((++sp & 255u) == 0u) { if (xb_ld(&bar[XB_TMO])) break; if (sp > XB_SPIN_CAP) { atomicAdd(&bar[XB_TMO], 1u); break; } }
    }
    nloc = mine > 0u ? mine : 1u; nx = cnt > 0u ? cnt : 1u;
}

__device__ __forceinline__ void xcd_barrier(const XcdBarrier& b) {
    asm volatile("s_waitcnt vmcnt(0)" ::: "memory");
    __syncthreads();
    if (opq_tid() == 0) {
        unsigned* bar = b.bar;
        __builtin_amdgcn_s_waitcnt(0);
        unsigned nloc = b.st[0], nx = b.st[1];
        if (nloc == 0u) { xcd_barrier_complete(bar, b.x, nloc, nx); b.st[0] = nloc; b.st[1] = nx; }
        const unsigned old = xb_add(&bar[XB_XSUB(b.x)], 1u);
        const unsigned gen = old / nloc;
        if (old + 1u == (gen + 1u) * nloc) {
            __builtin_amdgcn_fence(__ATOMIC_RELEASE, "agent");
            asm volatile("s_waitcnt vmcnt(0)" ::: "memory");
            const unsigned og = xb_add(&bar[XB_TOP], 1u);
            const unsigned tg = og / nx;
            if (og + 1u == (tg + 1u) * nx) xb_add(&bar[XB_TOPGEN], 1u);
            else XB_SPIN(xb_ld(&bar[XB_TOPGEN]) == tg, bar);
            __builtin_amdgcn_fence(__ATOMIC_ACQUIRE, "agent");
            xb_add(&bar[XB_XGEN(b.x)], 1u);
            asm volatile("s_waitcnt vmcnt(0)" ::: "memory");
        } else {
            XB_SPIN(xb_ld(&bar[XB_XGEN(b.x)]) == gen, bar);
            __builtin_amdgcn_fence(__ATOMIC_ACQUIRE, "agent");
            asm volatile("s_waitcnt vmcnt(0)" ::: "memory");
        }
    }
    __syncthreads();
}

namespace pg8 {
#define PG8_LAS __attribute__((address_space(3)))
typedef unsigned short bf16_t;
typedef short bf16x8 __attribute__((ext_vector_type(8)));
typedef float f32x4 __attribute__((ext_vector_type(4)));
typedef unsigned u32x4 __attribute__((ext_vector_type(4)));
constexpr int BM = 256, BK = 64, HALF = 128, HTB = HALF * BK * 2  , STAGE_BYTES = 8 * HTB, NXCD = 8, WGM = 8;

__host__ __device__ __forceinline__ int lds_byte(int r, int c) { const int st = (r >> 4) * 2 + (c >> 5), rr = r & 15, cc = c & 31, ob = rr * 64 + cc * 2; return st * 1024 + (ob ^ (((ob >> 9) & 1) << 5)); }
__host__ __device__ __forceinline__ void stage_rc(int b, int& R, int& C) { const int st = b / 1024, sb = b % 1024, swz = sb ^ (((sb >> 9) & 1) << 5); R = (st >> 1) * 16 + swz / 64; C = (st & 1) * 32 + (swz % 64) / 2; }
__host__ __device__ __forceinline__ int perm32(int rho) { const int n = rho >> 4, i = rho & 15; return 8 * (i >> 2) + 4 * n + (i & 3); }

struct Unit { int pm, pn; };
struct Gemm { const bf16_t* A; const bf16_t* Bt; int M, N, K; };

struct StaticOrder {
    int nM, nN, nwg, G, c;
    __host__ __device__ void init(int M, int N, int G_, int c_) { nM = M / BM; nN = N / BM; nwg = nM * nN; G = G_; c = c_; }
    __host__ __device__ bool next(int i, Unit& u) const {
        const long L = (long)i * G + c; if (L >= nwg) return false;
        int wgid = (int)L; { const int q = nwg / NXCD, r = nwg % NXCD, xcd = wgid % NXCD, off = wgid / NXCD; wgid = (xcd < r ? xcd * (q + 1) : r * (q + 1) + (xcd - r) * q) + off; }
        const int nig = WGM * nN, gid = wgid / nig, fm = gid * WGM, gsz = (nM - fm) < WGM ? (nM - fm) : WGM;
        u.pm = fm + ((wgid % nig) % gsz); u.pn = (wgid % nig) / gsz; return true;
    }
    __device__ __forceinline__ void a_ready(const Unit&) const {}
    __device__ __forceinline__ void done(const Unit&) const {}
};
__device__ __forceinline__ unsigned cvt_pk_bf16(float lo, float hi) { unsigned r; asm volatile("v_cvt_pk_bf16_f32 %0, %1, %2" : "=v"(r) : "v"(lo), "v"(hi)); return r; }
typedef float f32x2 __attribute__((ext_vector_type(2)));
__device__ __forceinline__ f32x2 gelu_pk(f32x2 v) {
    const f32x2 av = __builtin_elementwise_abs(v), d = av * 0.2316418882f + 1.0f;
    f32x2 t; t.x = __builtin_amdgcn_rcpf(d.x); t.y = __builtin_amdgcn_rcpf(d.y);
    f32x2 q = t * 0.5307027145f + (-0.7265760135f); q = q * t + 0.7107068705f; q = q * t + (-0.142248368f); q = q * t + 0.127414796f; q = q * t;
    const f32x2 s = (v * v) * (-0.72134752044f);
    f32x2 e; e.x = __builtin_amdgcn_exp2f(s.x); e.y = __builtin_amdgcn_exp2f(s.y);
    const f32x2 m = v * (q * e), r = v - m;
    f32x2 o; o.x = v.x < 0.f ? m.x : r.x; o.y = v.y < 0.f ? m.y : r.y; return o;
}

struct EpiF32 {
    static constexpr bool PERM = false, AFTER_DRAIN = false;
    float* C; int ldc; const float* bias;
    __device__ __forceinline__ void operator()(const f32x4 (&acc)[2][2][4][2], const Unit& u, int wr, int wc, int fr, int fq) const {
        const int row0 = u.pm * BM + wr * 64 + fr, col0 = u.pn * BM + wc * 32 + 4 * fq;
        f32x4 bv[2][2];
#pragma unroll
        for (int bj = 0; bj < 2; ++bj)
#pragma unroll
            for (int n = 0; n < 2; ++n) bv[bj][n] = bias ? *(const f32x4*)(bias + col0 + bj * HALF + n * 16) : (f32x4){0.f, 0.f, 0.f, 0.f};
#pragma unroll
        for (int ai = 0; ai < 2; ++ai)
#pragma unroll
            for (int m = 0; m < 4; ++m) { float* rowp = C + (size_t)(row0 + ai * HALF + m * 16) * ldc + col0;
#pragma unroll
                for (int bj = 0; bj < 2; ++bj)
#pragma unroll
                    for (int n = 0; n < 2; ++n) *(f32x4*)(rowp + bj * HALF + n * 16) = acc[ai][bj][m][n] + bv[bj][n]; }
    }
};
template <int ACT  > struct EpiBf16 {
    static constexpr bool PERM = true, AFTER_DRAIN = false;
    bf16_t* O; int ldc; const float* bias; int split_cols; size_t split_stride;
    __device__ __forceinline__ void operator()(const f32x4 (&acc)[2][2][4][2], const Unit& u, int wr, int wc, int fr, int fq) const {
        const int row0 = u.pm * BM + wr * 64 + fr; int colt = u.pn * BM; bf16_t* base = O;
        if (split_cols) { const int t = colt / split_cols; base += (size_t)t * split_stride; colt -= t * split_cols; }
        const int col0 = colt + wc * 32 + 8 * fq, bcol0 = u.pn * BM + wc * 32 + 8 * fq;
        f32x4 bv[2][2];
#pragma unroll
        for (int bj = 0; bj < 2; ++bj)
#pragma unroll
            for (int n = 0; n < 2; ++n) bv[bj][n] = bias ? *(const f32x4*)(bias + bcol0 + bj * HALF + 4 * n) : (f32x4){0.f, 0.f, 0.f, 0.f};
#pragma unroll
        for (int ai = 0; ai < 2; ++ai)
#pragma unroll
            for (int m = 0; m < 4; ++m) { bf16_t* rowp = base + (size_t)(row0 + ai * HALF + m * 16) * ldc + col0;
#pragma unroll
                for (int bj = 0; bj < 2; ++bj) { f32x4 v0 = acc[ai][bj][m][0] + bv[bj][0], v1 = acc[ai][bj][m][1] + bv[bj][1];
                    if (ACT == 1) { f32x2 a = gelu_pk((f32x2){v0[0], v0[1]}), b = gelu_pk((f32x2){v0[2], v0[3]}), c = gelu_pk((f32x2){v1[0], v1[1]}), d = gelu_pk((f32x2){v1[2], v1[3]});
                        v0 = (f32x4){a.x, a.y, b.x, b.y}; v1 = (f32x4){c.x, c.y, d.x, d.y}; }
                    if (ACT == 2) {
#pragma unroll
                        for (int j = 0; j < 4; ++j) { v0[j] = 0.5f * v0[j] * (1.0f + erff(v0[j] * 0.70710678f)); v1[j] = 0.5f * v1[j] * (1.0f + erff(v1[j] * 0.70710678f)); } }
                    u32x4 w; w.x = cvt_pk_bf16(v0[0], v0[1]); w.y = cvt_pk_bf16(v0[2], v0[3]); w.z = cvt_pk_bf16(v1[0], v1[1]); w.w = cvt_pk_bf16(v1[2], v1[3]);
                    *(u32x4*)(rowp + bj * HALF) = w; } }
    }
};

template <class Epi, class Sched, bool STAMP = false>
__device__ __forceinline__ void gemm_phase(PG8_LAS unsigned char* lds, const Gemm g, const Sched& S, const Epi& E, unsigned long long* stamps) {
    const int tid = opq_tid(), wid = __builtin_amdgcn_readfirstlane(tid >> 6), lane = tid & 63, wr = wid >> 2, wc = wid & 3, fr = lane & 15, fq = lane >> 4;
    const int K = g.K, nt = K / BK;
    int ts_lo = 0, ts_hi = 0, nts = 0; const unsigned long long rt_entry = STAMP ? (unsigned long long)wall_clock64() : 0ull;
#define PG8_STAMP() do { if (STAMP && wid == 0 && nts < 64) { const unsigned long long _c = (unsigned long long)clock64(); \
        ts_lo = (lane == nts) ? (int)(unsigned)_c : ts_lo; ts_hi = (lane == nts) ? (int)(unsigned)(_c >> 32) : ts_hi; ++nts; } } while (0)
    PG8_STAMP();
    unsigned voffA[2], voffB[2];
#pragma unroll
    for (int i = 0; i < 2; ++i) { int R, C; stage_rc(tid * 16 + i * 8192, R, C); const int Rb = Epi::PERM ? ((R & ~31) + perm32(R & 31)) : R;
        voffA[i] = (unsigned)(R * K + C) * 2u; voffB[i] = (unsigned)(Rb * K + C) * 2u; }
    const size_t kstep = (size_t)(BK * 2);
    const size_t hstep = (size_t)HALF * K * 2;
    const size_t tstep = 2 * hstep;
    const unsigned ldsw = (unsigned)wid * 1024u;
    const int aoff = lds_byte(wr * 64 + fr, fq * 8), boff = lds_byte(wc * 32 + fr, fq * 8);
#define PG8_SA(b, h) (((b) * 2 + (h)) * HTB)
#define PG8_SB(b, h) ((4 + (b) * 2 + (h)) * HTB)
#define PG8_STAGE(bufoff, gbase, voff) do { _Pragma("unroll") for (int _i = 0; _i < 2; ++_i) \
        __builtin_amdgcn_global_load_lds((const unsigned*)((const char*)(gbase) + (voff)[_i]), (PG8_LAS unsigned*)(lds + (bufoff) + ldsw + _i * 8192), 16, 0, 0); } while (0)
#define PG8_LDA(dst, b, h) do { _Pragma("unroll") for (int m = 0; m < 4; ++m) _Pragma("unroll") for (int k = 0; k < 2; ++k) dst[m][k] = *(const PG8_LAS bf16x8*)(lds + PG8_SA(b, h) + aoff + m * 2048 + k * 1024); } while (0)
#define PG8_LDB(dst, b, h) do { _Pragma("unroll") for (int n = 0; n < 2; ++n) _Pragma("unroll") for (int k = 0; k < 2; ++k) dst[n][k] = *(const PG8_LAS bf16x8*)(lds + PG8_SB(b, h) + boff + n * 2048 + k * 1024); } while (0)
#define PG8_MMA(ai, bj, At, Bt) do { __builtin_amdgcn_s_setprio(1); _Pragma("unroll") for (int m = 0; m < 4; ++m) _Pragma("unroll") for (int n = 0; n < 2; ++n) _Pragma("unroll") for (int k = 0; k < 2; ++k) \
        acc[ai][bj][m][n] = __builtin_amdgcn_mfma_f32_16x16x32_bf16(Bt[n][k], At[m][k], acc[ai][bj][m][n], 0, 0, 0); __builtin_amdgcn_s_setprio(0); } while (0)
#define PG8_WAIT_V(n) asm volatile("s_waitcnt vmcnt(" #n ")" ::: "memory")
#define PG8_WAIT_L(n) asm volatile("s_waitcnt lgkmcnt(" #n ")" ::: "memory")
#define PG8_BAR __builtin_amdgcn_s_barrier()
#define PG8_SCHED __builtin_amdgcn_sched_barrier(0)
    Unit cur, nxt; int ui = 0;
    if (!S.next(0, cur)) return;
    f32x4 acc[2][2][4][2];
#pragma unroll
    for (int a = 0; a < 2; ++a)
#pragma unroll
        for (int b = 0; b < 2; ++b)
#pragma unroll
            for (int m = 0; m < 4; ++m)
#pragma unroll
                for (int n = 0; n < 2; ++n) acc[a][b][m][n] = (f32x4){0.f, 0.f, 0.f, 0.f};
    bf16x8 At[4][2], B0[2][2], B1[2][2];
    const char* cA = (const char*)g.A + (size_t)cur.pm * tstep; const char* cB = (const char*)g.Bt + (size_t)cur.pn * tstep;
    S.a_ready(cur);
    PG8_STAGE(PG8_SB(0, 0), cB, voffB); PG8_STAGE(PG8_SA(0, 0), cA, voffA); PG8_STAGE(PG8_SB(0, 1), cB + hstep, voffB); PG8_STAGE(PG8_SA(0, 1), cA + hstep, voffA);
    if (wr == 1) PG8_BAR;
    PG8_WAIT_V(4); PG8_BAR;
    PG8_STAGE(PG8_SB(1, 0), cB + kstep, voffB); PG8_STAGE(PG8_SA(1, 0), cA + kstep, voffA); PG8_STAGE(PG8_SB(1, 1), cB + hstep + kstep, voffB);
    PG8_WAIT_V(6); PG8_BAR;
    PG8_STAMP();
    for (;;) {
        const bool has_next = S.next(ui + 1, nxt);
        const char* nA = has_next ? (const char*)g.A + (size_t)nxt.pm * tstep : cA; const char* nB = has_next ? (const char*)g.Bt + (size_t)nxt.pn * tstep : cB;
        for (int t = 0; t < nt; t += 2) {
            const bool last = (t == nt - 2);
            const char* a1 = cA + (size_t)(t + 1) * kstep;
            const char* a2 = last ? nA : cA + (size_t)(t + 2) * kstep; const char* b2 = last ? nB : cB + (size_t)(t + 2) * kstep;
            const char* a3 = a2 + kstep; const char* b3 = b2 + kstep;
            if (last && has_next) S.a_ready(nxt);
            PG8_LDB(B0, 0, 0); PG8_SCHED; PG8_LDA(At, 0, 0); PG8_STAGE(PG8_SA(1, 1), a1 + hstep, voffA);
            PG8_WAIT_L(8); PG8_BAR; PG8_WAIT_L(0); PG8_MMA(0, 0, At, B0); PG8_BAR; PG8_SCHED;
            PG8_LDB(B1, 0, 1); PG8_STAGE(PG8_SB(0, 0), b2, voffB);
            PG8_BAR; PG8_WAIT_L(0); PG8_MMA(0, 1, At, B1); PG8_BAR;
            PG8_LDA(At, 0, 1); PG8_STAGE(PG8_SA(0, 0), a2, voffA);
            PG8_BAR; PG8_WAIT_L(0); PG8_MMA(1, 0, At, B0); PG8_BAR; PG8_SCHED;
            PG8_STAGE(PG8_SB(0, 1), b2 + hstep, voffB);
            PG8_WAIT_V(6); PG8_BAR; PG8_MMA(1, 1, At, B1); PG8_BAR;
            PG8_LDB(B0, 1, 0); PG8_SCHED; PG8_LDA(At, 1, 0); PG8_STAGE(PG8_SA(0, 1), a2 + hstep, voffA);
            PG8_WAIT_L(8); PG8_BAR; PG8_WAIT_L(0); PG8_MMA(0, 0, At, B0); PG8_BAR; PG8_SCHED;
            PG8_LDB(B1, 1, 1); PG8_STAGE(PG8_SB(1, 0), b3, voffB);
            PG8_BAR; PG8_WAIT_L(0); PG8_MMA(0, 1, At, B1); PG8_BAR;
            PG8_LDA(At, 1, 1); PG8_STAGE(PG8_SA(1, 0), a3, voffA);
            PG8_BAR; PG8_WAIT_L(0); PG8_MMA(1, 0, At, B0); PG8_BAR; PG8_SCHED;
            PG8_STAGE(PG8_SB(1, 1), b3 + hstep, voffB);
            PG8_WAIT_V(6); PG8_BAR; PG8_MMA(1, 1, At, B1); PG8_BAR;
        }
        PG8_STAMP();
        if constexpr (!Epi::AFTER_DRAIN) { E(acc, cur, wr, wc, fr, fq); S.done(cur); }
        PG8_STAMP();
        if (!has_next) break;
#pragma unroll
        for (int a = 0; a < 2; ++a)
#pragma unroll
            for (int b = 0; b < 2; ++b)
#pragma unroll
                for (int m = 0; m < 4; ++m)
#pragma unroll
                    for (int n = 0; n < 2; ++n) acc[a][b][m][n] = (f32x4){0.f, 0.f, 0.f, 0.f};
        cur = nxt; cA = nA; cB = nB; ++ui;
    }
    PG8_WAIT_V(0);
    if (wr == 0) PG8_BAR;
    PG8_BAR;
    if constexpr (Epi::AFTER_DRAIN) { E.fused(acc, cur, wr, wc, fr, fq, lds, wid, lane); S.done(cur); }
    PG8_STAMP();
    if (STAMP && wid == 0) { stamps[lane] = lane < nts ? (((unsigned long long)(unsigned)ts_hi << 32) | (unsigned)ts_lo) : 0ull;
        if (lane == 62) stamps[62] = rt_entry; if (lane == 63) stamps[63] = (unsigned long long)wall_clock64(); }
#undef PG8_STAMP
#undef PG8_SA
#undef PG8_SB
#undef PG8_STAGE
#undef PG8_LDA
#undef PG8_LDB
#undef PG8_MMA
#undef PG8_WAIT_V
#undef PG8_WAIT_L
#undef PG8_BAR
#undef PG8_SCHED
}
}
namespace da {
constexpr int D = 128;
constexpr int LDI = 128, LDO = 2048;
constexpr float THR = 8.f;
constexpr bool WSKIP = false;
constexpr float SCALE = 0.08838834764831845f;
constexpr int NW = 8, QBLK = 32, KVBLK = 64, QB = NW * QBLK;
constexpr int SHM_V = KVBLK * D * 2, SHM_K = KVBLK * D * 2;
constexpr int LDS_BYTES = 2 * SHM_V + 2 * SHM_K + NW * 64 * 4;

using bf16 = __hip_bfloat16;
typedef short bf16x8 __attribute__((ext_vector_type(8)));
typedef short s16x4 __attribute__((ext_vector_type(4)));
typedef float f32x16 __attribute__((ext_vector_type(16)));
typedef float f32x4 __attribute__((ext_vector_type(4)));
typedef unsigned u32x4 __attribute__((ext_vector_type(4)));
template <class A, class Bt> struct same_t { static constexpr bool v = false; };
template <class A> struct same_t<A, A> { static constexpr bool v = true; };

#define KSWZ(row, colB) ((row) * 256 + ((colB) ^ (((row) & 7) << 4)))
#define SBAR() __builtin_amdgcn_sched_barrier(0)
__device__ __forceinline__ int v_st(int k, int c) { const int kk = (k & ~0xC) | ((k & 4) << 1) | ((k & 8) >> 1); return ((kk >> 3) * 4 + (c >> 5)) * 512 + ((kk & 7) * 32 + (c & 31)) * 2; }
__device__ __forceinline__ int v_rd_base(int lane) { return ((lane & 3) << 3) | (((lane >> 2) & 3) << 6) | (((lane >> 4) & 1) << 5) | (((lane >> 5) & 1) << 8); }
constexpr int v_rd_off(int d0, int ks, int half) { return d0 * 512 + ks * 4096 + half * 2048; }
__device__ __forceinline__ int crow(int r, int hi) { return (r & 3) + 8 * (r >> 2) + 4 * hi; }
__device__ __forceinline__ unsigned cvtpk(float lo, float hi) {
    unsigned r; asm volatile("v_cvt_pk_bf16_f32 %0, %1, %2" : "=v"(r) : "v"(lo), "v"(hi)); return r;
}
__device__ __forceinline__ bf16x8 pack8(f32x4 a, f32x4 b) {
    u32x4 w = {cvtpk(a[0], a[1]), cvtpk(a[2], a[3]), cvtpk(b[0], b[1]), cvtpk(b[2], b[3])};
    return *reinterpret_cast<bf16x8*>(&w);
}
template <class T> __device__ __forceinline__ bf16x8 load8(const T* p) {
    if constexpr (same_t<T, float>::v) { return pack8(*(const f32x4*)p, *(const f32x4*)(p + 4)); }
    else { return *reinterpret_cast<const bf16x8*>(p); }
}
__device__ __forceinline__ void mask_tile(f32x16& p0, f32x16& p1, int dq, unsigned W) {
    const float NEG = -__builtin_inff();
#pragma unroll
    for (int r = 0; r < 16; ++r) {
        const int c = (r & 3) + 8 * (r >> 2);
        if ((unsigned)(dq - c) >= W) p0[r] = NEG;
        if ((unsigned)(dq - c - 32) >= W) p1[r] = NEG;
    }
}
__device__ __forceinline__ void partialSM(f32x16& p0, f32x16& p1, float& m_reg, float& mn, float& alpha) {
    float pmax = p0[0]; for (int r = 1; r < 16; ++r) pmax = fmaxf(pmax, p0[r]); for (int r = 0; r < 16; ++r) pmax = fmaxf(pmax, p1[r]);
    { auto rr = __builtin_amdgcn_permlane32_swap(__float_as_uint(pmax), __float_as_uint(pmax), false, false);
      pmax = fmaxf(__uint_as_float(rr[0]), __uint_as_float(rr[1])); }
    constexpr float C2 = 1.4426950408889634f * SCALE;
    if (__builtin_expect(__all((pmax - m_reg) * SCALE <= THR), 1)) { mn = m_reg; alpha = 1.f; }
    else { mn = fmaxf(m_reg, pmax); alpha = __builtin_amdgcn_exp2f((m_reg - mn) * C2); m_reg = mn; }
    const float mnL = -mn * C2;
    for (int r = 0; r < 16; ++r) p0[r] = fmaf(p0[r], C2, mnL); for (int r = 0; r < 16; ++r) p1[r] = fmaf(p1[r], C2, mnL);
    for (int r = 0; r < 16; ++r) p0[r] = __builtin_amdgcn_exp2f(p0[r]);
}
__device__ __forceinline__ void finishSM(f32x16& p0, f32x16& p1, float alpha, float& l_reg, bf16x8& pa0, bf16x8& pa1, bf16x8& pa2, bf16x8& pa3) {
    for (int r = 0; r < 16; ++r) p1[r] = __builtin_amdgcn_exp2f(p1[r]);
    float ps = 0; for (int r = 0; r < 16; ++r) ps += p0[r]; for (int r = 0; r < 16; ++r) ps += p1[r];
    { auto rr = __builtin_amdgcn_permlane32_swap(__float_as_uint(ps), __float_as_uint(ps), false, false);
      ps = __uint_as_float(rr[0]) + __uint_as_float(rr[1]); }
    l_reg = l_reg * alpha + ps;
#define PK4(P, B_, OUT) do { unsigned a0 = cvtpk(P[B_+0], P[B_+1]), a1 = cvtpk(P[B_+2], P[B_+3]);                          \
        unsigned b0 = cvtpk(P[B_+4], P[B_+5]), b1 = cvtpk(P[B_+6], P[B_+7]);                                             \
        auto r0 = __builtin_amdgcn_permlane32_swap(a0, b0, false, false); auto r1 = __builtin_amdgcn_permlane32_swap(a1, b1, false, false); \
        u32x4 w = {r0[0], r1[0], r0[1], r1[1]}; OUT = *reinterpret_cast<bf16x8*>(&w); } while (0)
    PK4(p0, 0, pa0); PK4(p0, 8, pa1); PK4(p1, 0, pa2); PK4(p1, 8, pa3);
#undef PK4
}
template <int KB, bool SK>
__device__ __forceinline__ void qkt(f32x16& p0, f32x16& p1, const char* K_lds, int r32, int hi, const bf16x8* qr, bool act) {
    if (SK && !act) { const float NEG = -__builtin_inff();
#pragma unroll
        for (int r = 0; r < 16; ++r) { p0[r] = NEG; p1[r] = NEG; } return; }
    p0 = f32x16{}; p1 = f32x16{};
    const char* kb[4];
#pragma unroll
    for (int dd = 0; dd < 4; ++dd) kb[dd] = K_lds + KB * SHM_K + KSWZ(r32, (dd * 16 + hi * 8) * 2);
#pragma unroll
    for (int d0 = 0; d0 < 8; ++d0) { const char* a = kb[d0 & 3] + (d0 >> 2) * 128;
        bf16x8 b0 = *reinterpret_cast<const bf16x8*>(a);
        bf16x8 b1 = *reinterpret_cast<const bf16x8*>(a + 32 * 256);
        p0 = __builtin_amdgcn_mfma_f32_32x32x16_bf16(b0, qr[d0], p0, 0, 0, 0);
        p1 = __builtin_amdgcn_mfma_f32_32x32x16_bf16(b1, qr[d0], p1, 0, 0, 0); }
}
template <int VB, bool SK>
__device__ __forceinline__ void pv_tile(f32x16* o, int vb0, bf16x8 pa0, bf16x8 pa1, bf16x8 pa2, bf16x8 pa3, bool act) {
    if (SK && !act) return;
#define TRRD(dst, off) asm volatile("ds_read_b64_tr_b16 %0, %1 offset:%2" : "=&v"(dst) : "v"(vb0), "i"(off) : "memory")
#define PV_D0(d0) do { s16x4 l0, l1, l2, l3, h0, h1, h2, h3; constexpr int b_ = VB * SHM_V + v_rd_off(d0, 0, 0);     \
        TRRD(l0, b_); TRRD(h0, b_ + 2048); TRRD(l1, b_ + 4096); TRRD(h1, b_ + 6144); TRRD(l2, b_ + 8192); TRRD(h2, b_ + 10240); TRRD(l3, b_ + 12288); TRRD(h3, b_ + 14336); \
        asm volatile("s_waitcnt lgkmcnt(0)" ::: "memory"); SBAR();                 \
        o[d0] = __builtin_amdgcn_mfma_f32_32x32x16_bf16(pa0, (bf16x8){l0[0], l0[1], l0[2], l0[3], h0[0], h0[1], h0[2], h0[3]}, o[d0], 0, 0, 0);   \
        o[d0] = __builtin_amdgcn_mfma_f32_32x32x16_bf16(pa1, (bf16x8){l1[0], l1[1], l1[2], l1[3], h1[0], h1[1], h1[2], h1[3]}, o[d0], 0, 0, 0);   \
        o[d0] = __builtin_amdgcn_mfma_f32_32x32x16_bf16(pa2, (bf16x8){l2[0], l2[1], l2[2], l2[3], h2[0], h2[1], h2[2], h2[3]}, o[d0], 0, 0, 0);   \
        o[d0] = __builtin_amdgcn_mfma_f32_32x32x16_bf16(pa3, (bf16x8){l3[0], l3[1], l3[2], l3[3], h3[0], h3[1], h3[2], h3[3]}, o[d0], 0, 0, 0); } while (0)
    PV_D0(0); PV_D0(1); PV_D0(2); PV_D0(3);
#undef PV_D0
#undef TRRD
}

template <class TIn, class TOut> struct BlockRef { const TIn* Q; const TIn* K; const TIn* V; TOut* O; int P0; };
template <class TIn> struct Seam {
    bf16x8 qr[8];
    bf16x8 st_v0, st_v1, st_k0, st_k1; f32x4 sf0, sf1, sf2, sf3;
    f32x4 tq[16];
};
__device__ __forceinline__ int swa_jlo(int P0, int W) { const int lowk = P0 - W + 1; return lowk > 0 ? lowk / KVBLK : 0; }
#define ROW(p, k0, rr) ((p) + (size_t)((k0) + (rr)) * LDI + sc)
#define VMW() asm volatile("s_waitcnt vmcnt(0)" ::: "memory")
#define VMWN(n) asm volatile("s_waitcnt vmcnt(%0)" :: "i"(n) : "memory")
#define SLOAD_H(Kp, Vp, k0) do { S.st_v0 = load8<TIn>(ROW(Vp, k0, sr)); S.st_v1 = load8<TIn>(ROW(Vp, k0, 32 + sr));              \
                         S.st_k0 = load8<TIn>(ROW(Kp, k0, sr)); S.st_k1 = load8<TIn>(ROW(Kp, k0, 32 + sr)); } while (0)
#define SWRITE_HK(bf) do { *(bf16x8*)(K_lds + (bf) * SHM_K + kws) = S.st_k0; *(bf16x8*)(K_lds + (bf) * SHM_K + kws + 32 * 256) = S.st_k1; } while (0)
#define SWRITE_HV(bf) do { *(bf16x8*)(V_lds + (bf) * SHM_V + vst0) = S.st_v0; *(bf16x8*)(V_lds + (bf) * SHM_V + vst1) = S.st_v1; } while (0)
#define SWRITE_H(bf) do { SWRITE_HV(bf); SWRITE_HK(bf); } while (0)
#define SLOAD_F(p, k0) do { S.sf0 = *(const f32x4*)ROW(p, k0, sr); S.sf1 = *(const f32x4*)(ROW(p, k0, sr) + 4);                \
                            S.sf2 = *(const f32x4*)ROW(p, k0, 32 + sr); S.sf3 = *(const f32x4*)(ROW(p, k0, 32 + sr) + 4); } while (0)
#define SWRITE_KF(bf) do { *(bf16x8*)(K_lds + (bf) * SHM_K + kws) = pack8(S.sf0, S.sf1); *(bf16x8*)(K_lds + (bf) * SHM_K + kws + 32 * 256) = pack8(S.sf2, S.sf3); } while (0)
#define SWRITE_VF(bf) do { *(bf16x8*)(V_lds + (bf) * SHM_V + vst0) = pack8(S.sf0, S.sf1); *(bf16x8*)(V_lds + (bf) * SHM_V + vst1) = pack8(S.sf2, S.sf3); } while (0)
template <class TIn, class TOut>
__device__ __forceinline__ void causal_swa_prime(const BlockRef<TIn, TOut>& cur, int W, char* lds, Seam<TIn>& S) {
    constexpr bool F32 = same_t<TIn, float>::v;
    const int tid = opq_tid(), wid = __builtin_amdgcn_readfirstlane(tid >> 6), lane = tid & 63, r32 = lane & 31, hi = lane >> 5;
    const int sr = tid >> 4, sc = (tid & 15) * 8, kws = KSWZ(sr, sc * 2); char* K_lds = lds + 2 * SHM_V;
    const int kb0 = swa_jlo(cur.P0, W) * KVBLK;
    for (int d0 = 0; d0 < 8; ++d0) S.qr[d0] = load8<TIn>(cur.Q + (size_t)(wid * QBLK + r32) * LDI + d0 * 16 + hi * 8);
    if constexpr (F32) { SLOAD_F((const float*)cur.K, kb0); VMW(); SWRITE_KF(0); SBAR(); SLOAD_F((const float*)cur.V, kb0); }
    else { SLOAD_H(cur.K, cur.V, kb0); VMW(); SWRITE_HK(0); }
    __syncthreads();
}
template <class TIn, class TOut>
__device__ __forceinline__ void causal_swa_block(const BlockRef<TIn, TOut>& cur, const BlockRef<TIn, TOut>& nxt, int skv, int W, char* lds, Seam<TIn>& S) {
    constexpr bool F32 = same_t<TIn, float>::v;
    const int tid = opq_tid(), wid = __builtin_amdgcn_readfirstlane(tid >> 6), lane = tid & 63, r32 = lane & 31, hi = lane >> 5;
    const int j_lo = swa_jlo(cur.P0, W);
    int j_hi = (cur.P0 + QB - 1) / KVBLK + 1; if (j_hi > skv / KVBLK) j_hi = skv / KVBLK;
    const int NT = j_hi - j_lo;
    const int kbn = swa_jlo(nxt.P0, W) * KVBLK;
    const int qlo = cur.P0 + wid * QBLK, qm = qlo + r32 - 4 * hi;
    char* V_lds = lds; char* K_lds = lds + 2 * SHM_V;
    float* ws = (float*)(lds + 2 * SHM_V + 2 * SHM_K) + wid * 64; float* li_l = ws, * al_l = ws + 32;
    float m_reg = -1e30f, l_reg = 0; f32x16 o[4] = {};
    const int sr = tid >> 4, sc = (tid & 15) * 8, vst0 = v_st(sr, sc), vst1 = v_st(32 + sr, sc), kws = KSWZ(sr, sc * 2);
    const int vb0 = (int)(uintptr_t)V_lds + v_rd_base(lane);
    const TIn* Kh = cur.K; const TIn* Vh = cur.V;
#define RESC(a) do { if (__any((a) < 1.f)) { if (hi == 0) al_l[r32] = (a); asm volatile("s_waitcnt lgkmcnt(0)" ::: "memory");              \
                     for (int d_ = 0; d_ < 4; ++d_) for (int r = 0; r < 16; ++r) o[d_][r] *= al_l[crow(r, hi)]; } } while (0)
#define KBASE(t) ((j_lo + (t)) * KVBLK)
#define ACT(t) (KBASE(t) <= qlo + QBLK - 1 && KBASE(t) + KVBLK - 1 >= qlo - W + 1)
#define MASKT(P0_, P1_, t) do { const int kb_ = KBASE(t); if ((!SK || ACT(t)) && (kb_ + KVBLK - 1 > qlo || kb_ <= qlo + QBLK - 1 - W)) mask_tile(P0_, P1_, qm - kb_, (unsigned)W); } while (0)
    constexpr int NQL = F32 ? 16 : 8;
    constexpr bool SK = WSKIP && !F32;
#define SEAM_K0() do { VMWN(NQL); if constexpr (F32) { SWRITE_KF(0); SBAR(); SLOAD_F((const float*)nxt.V, kbn); } else { SWRITE_HK(0); } SBAR(); } while (0)
    f32x16 pA0, pA1, pB0, pB1; float mnA, mnB, alA, alB; bf16x8 pa0, pa1, pa2, pa3;
    if constexpr (F32) { VMW(); SWRITE_VF(0); SBAR(); } else { SWRITE_HV(0); SBAR(); }
    if (NT > 1) { if constexpr (F32) SLOAD_F((const float*)Kh, KBASE(1)); else SLOAD_H(Kh, Vh, KBASE(1)); }
    SBAR(); qkt<0, SK>(pA0, pA1, K_lds, r32, hi, S.qr, ACT(0));
    if constexpr (F32) { if (NT > 1) { VMW(); SWRITE_KF(1); SBAR(); SLOAD_F((const float*)Vh, KBASE(1)); } }
    MASKT(pA0, pA1, 0); partialSM(pA0, pA1, m_reg, mnA, alA);
    if (NT > 1) { VMW(); if constexpr (F32) { SWRITE_VF(1); SBAR(); if (NT > 2) SLOAD_F((const float*)Kh, KBASE(2)); } else SWRITE_H(1); }
    __syncthreads();
#define HALF_STEP(PX0, PX1, mnX, alX, PY0, PY1, alY, t, KB, VB, SB) do {                                                      \
        SBAR(); qkt<KB, SK>(PX0, PX1, K_lds, r32, hi, S.qr, ACT(t));                                             \
        finishSM(PY0, PY1, alY, l_reg, pa0, pa1, pa2, pa3); SBAR();                                                           \
        if ((t) + 1 < NT) { if constexpr (F32) { VMW(); SWRITE_KF(SB); SBAR(); SLOAD_F((const float*)Vh, KBASE((t) + 1)); }  \
                            else { SLOAD_H(Kh, Vh, KBASE((t) + 1)); } SBAR(); }                                               \
        pv_tile<VB, SK>(o, vb0, pa0, pa1, pa2, pa3, ACT((t) - 1)); MASKT(PX0, PX1, (t)); partialSM(PX0, PX1, m_reg, mnX, alX);                                        \
        __syncthreads();                                                                                                      \
        if ((t) + 1 < NT) { VMW(); if constexpr (F32) { SWRITE_VF(SB); SBAR(); if ((t) + 2 < NT) SLOAD_F((const float*)Kh, KBASE((t) + 2)); } \
                            else { SWRITE_H(SB); } }                                                                          \
        RESC(alX); __syncthreads(); } while (0)
    for (int t = 1; t + 1 < NT; t += 2) {
        HALF_STEP(pB0, pB1, mnB, alB, pA0, pA1, alA, t, 1, 0, 0);
        HALF_STEP(pA0, pA1, mnA, alA, pB0, pB1, alB, t + 1, 0, 1, 1);
    }
    const bool even = (NT & 1) == 0;
    if (even) { SBAR(); qkt<1, SK>(pB0, pB1, K_lds, r32, hi, S.qr, ACT(NT - 1)); SBAR(); }
#define QROW(e) (nxt.Q + (size_t)(wid * QBLK + r32) * LDI + ((e) >> 1) * 16 + hi * 8 + ((e) & 1) * 4)
    if constexpr (F32) { SLOAD_F((const float*)nxt.K, kbn); SBAR();
#pragma unroll
        for (int e = 0; e < 8; ++e) S.tq[e] = *(const f32x4*)QROW(e); }
    else { SLOAD_H(nxt.K, nxt.V, kbn); SBAR();
#pragma unroll
        for (int d0 = 0; d0 < 8; ++d0) S.qr[d0] = load8<TIn>(nxt.Q + (size_t)(wid * QBLK + r32) * LDI + d0 * 16 + hi * 8); }
    SBAR();
    finishSM(pA0, pA1, alA, l_reg, pa0, pa1, pa2, pa3); SBAR();
    if constexpr (F32) {
#pragma unroll
        for (int e = 8; e < 16; ++e) S.tq[e] = *(const f32x4*)QROW(e); SBAR(); }
#undef QROW
    pv_tile<0, SK>(o, vb0, pa0, pa1, pa2, pa3, ACT(even ? NT - 2 : NT - 1));
    if (even) { MASKT(pB0, pB1, NT - 1); partialSM(pB0, pB1, m_reg, mnB, alB); __syncthreads(); RESC(alB);
        finishSM(pB0, pB1, alB, l_reg, pa0, pa1, pa2, pa3); SBAR(); pv_tile<1, SK>(o, vb0, pa0, pa1, pa2, pa3, ACT(NT - 1)); }
    SBAR(); SEAM_K0();
    if (hi == 0) li_l[r32] = l_reg; asm volatile("s_waitcnt lgkmcnt(0)" ::: "memory");
    float rli[16];
#pragma unroll
    for (int r = 0; r < 16; ++r) rli[r] = __builtin_amdgcn_rcpf(li_l[crow(r, hi)]);
    TOut* Ow = cur.O + (size_t)(wid * QBLK) * LDO;
#pragma unroll
    for (int r = 0; r < 16; ++r) { const int orow = crow(r, hi);
#pragma unroll
        for (int d0 = 0; d0 < 4; ++d0) { const float v = o[d0][r] * rli[r];
            if constexpr (same_t<TOut, float>::v) { Ow[(size_t)orow * LDO + d0 * 32 + r32] = v; }
            else { const float vn = __shfl_xor(v, 1);
                   if ((r32 & 1) == 0) *(unsigned*)(Ow + (size_t)orow * LDO + d0 * 32 + r32) = cvtpk(v, vn); } } }
    if constexpr (F32) {
#pragma unroll
        for (int d0 = 0; d0 < 8; ++d0) S.qr[d0] = pack8(S.tq[2 * d0], S.tq[2 * d0 + 1]); }
    __syncthreads();
#undef RESC
#undef KBASE
#undef ACT
#undef MASKT
#undef SEAM_K0
#undef HALF_STEP
}
#undef ROW
#undef VMW
#undef VMWN
#undef SLOAD_H
#undef SWRITE_HK
#undef SWRITE_HV
#undef SWRITE_H
#undef SLOAD_F
#undef SWRITE_KF
#undef SWRITE_VF
}

typedef unsigned short u16;
typedef short bf16x8_t __attribute__((ext_vector_type(8)));
typedef float f32x4_t __attribute__((ext_vector_type(4)));
typedef unsigned u32x4_t __attribute__((ext_vector_type(4)));

constexpr int T_ = 16384, S_ = 4096, DM = 2048, DFF = 5504, NGU = 11008, NPJ = 7168, PW = 7176;
constexpr int NTHR = 512;
constexpr size_t PBLK = (size_t)T_ * 128;
constexpr int LDT = 136;

constexpr size_t OFF_TAB = 0;
constexpr size_t SZ_TAB = (size_t)4096 * 64 * 4 * 2 + (size_t)4096 * 16 * 4 * 2;
constexpr size_t OFF_WGU1 = OFF_TAB + SZ_TAB;
constexpr size_t SZ_WGU = (size_t)NGU * DM * 2;
constexpr size_t OFF_WD1 = OFF_WGU1 + SZ_WGU;
constexpr size_t SZ_WD = (size_t)DM * DFF * 2;
constexpr size_t OFF_WIN = OFF_WD1 + SZ_WD;
constexpr size_t SZ_WIN = (size_t)NPJ * DM * 2;
constexpr size_t OFF_WOUT = OFF_WIN + SZ_WIN;
constexpr size_t SZ_WOUT = (size_t)DM * DM * 2;
constexpr size_t OFF_WGU2 = OFF_WOUT + SZ_WOUT;
constexpr size_t OFF_WD2 = OFF_WGU2 + SZ_WGU;
constexpr size_t OFF_XB = OFF_WD2 + SZ_WD;
constexpr size_t SZ_XB = (size_t)T_ * DM * 2;
constexpr size_t OFF_HP = OFF_XB + SZ_XB;
constexpr size_t SZ_HP = (size_t)T_ * NPJ * 2;
constexpr size_t OFF_Z = OFF_HP + SZ_HP;
constexpr size_t SZ_Z = (size_t)T_ * DM * 4;
constexpr size_t OFF_GATE = OFF_Z + SZ_Z;
constexpr size_t SZ_GATE = (size_t)T_ * 8 * 4;
constexpr size_t OFF_MQK = OFF_GATE + SZ_GATE;
constexpr size_t SZ_MQK = (size_t)T_ * 1024 * 2;
constexpr size_t OFF_STR = OFF_MQK + SZ_MQK;
constexpr size_t SZ_STR = (size_t)16 * 32 * 16384 * 4;
constexpr size_t OFF_STM = OFF_STR + SZ_STR;
constexpr size_t SZ_STM = (size_t)16 * 64 * 16384 * 4;
constexpr size_t OFF_NM = OFF_STM + SZ_STM;
constexpr size_t SZ_NM = (size_t)16 * 64 * 128 * 4;
constexpr size_t OFF_SC = OFF_NM + SZ_NM;
constexpr size_t SZ_SC = (size_t)16 * 64 * 4 * 4;
constexpr size_t OFF_MIX = OFF_SC + SZ_SC;
constexpr size_t SZ_MIX = (size_t)T_ * DM * 2;
constexpr size_t OFF_STAT = OFF_MIX + SZ_MIX;
constexpr size_t SZ_STAT = (size_t)6 * T_ * 2 * 4;
constexpr size_t OFF_CS = OFF_STAT + SZ_STAT;
constexpr int CS_LAYER = 2 * NPJ + 4 * NGU;
constexpr size_t SZ_CS = (size_t)2 * CS_LAYER * 4;
constexpr size_t OFF_BAR = OFF_CS + SZ_CS;
constexpr size_t SZ_BAR = 16384;
constexpr size_t WS_END = OFF_BAR + SZ_BAR;

constexpr int LDS_PHASE = 4 * 128 * LDT * 2 + 7 * 128 * 4;
constexpr int LDS_TOTAL = LDS_PHASE + 16;

struct Params { const float* in[16]; float* out; unsigned char* ws; };

__device__ __forceinline__ u16 f2bf(float f) { return (u16)(pg8::cvt_pk_bf16(f, 0.f) & 0xffffu); }
__device__ __forceinline__ float bf2f(u16 b) { return __uint_as_float(((unsigned)b) << 16); }
__device__ __forceinline__ unsigned pk2(float a, float b) { return pg8::cvt_pk_bf16(a, b); }
__device__ __forceinline__ float shx(float v, int o, int lane) { return __int_as_float(__builtin_amdgcn_ds_bpermute((lane ^ o) << 2, __float_as_int(v))); }
__device__ __forceinline__ float shup(float v, int o, int lane) { return __int_as_float(__builtin_amdgcn_ds_bpermute(((lane - o) & 63) << 2, __float_as_int(v))); }
__device__ __forceinline__ float dpp_f(float v, int ctrl_sel) {
    const int x = __float_as_int(v);
    int r;
    if (ctrl_sel == 0) r = __builtin_amdgcn_update_dpp(x, x, 0xB1, 0xF, 0xF, false);
    else if (ctrl_sel == 1) r = __builtin_amdgcn_update_dpp(x, x, 0x4E, 0xF, 0xF, false);
    else if (ctrl_sel == 2) r = __builtin_amdgcn_update_dpp(x, x, 0x124, 0xF, 0xF, false);
    else r = __builtin_amdgcn_update_dpp(x, x, 0x128, 0xF, 0xF, false);
    return __int_as_float(r);
}
__device__ __forceinline__ float wave_sum(float v, int lane) {
    (void)lane;
    v += dpp_f(v, 0); v += dpp_f(v, 1); v += dpp_f(v, 2); v += dpp_f(v, 3);
    const int x = __float_as_int(v);
    return (__int_as_float(__builtin_amdgcn_readlane(x, 0)) + __int_as_float(__builtin_amdgcn_readlane(x, 16))) + (__int_as_float(__builtin_amdgcn_readlane(x, 32)) + __int_as_float(__builtin_amdgcn_readlane(x, 48)));
}
__device__ __forceinline__ float wave_max(float v, int lane) {
    (void)lane;
    v = fmaxf(v, dpp_f(v, 0)); v = fmaxf(v, dpp_f(v, 1)); v = fmaxf(v, dpp_f(v, 2)); v = fmaxf(v, dpp_f(v, 3));
    const int x = __float_as_int(v);
    return fmaxf(fmaxf(__int_as_float(__builtin_amdgcn_readlane(x, 0)), __int_as_float(__builtin_amdgcn_readlane(x, 16))), fmaxf(__int_as_float(__builtin_amdgcn_readlane(x, 32)), __int_as_float(__builtin_amdgcn_readlane(x, 48))));
}
__device__ __forceinline__ float scan_sum(float v, int lane) {
#pragma unroll
    for (int o = 1; o < 64; o <<= 1) { const float t = shup(v, o, lane); if (lane >= o) v += t; }
    return v;
}
__device__ __forceinline__ float scan_max(float v, int lane) {
#pragma unroll
    for (int o = 1; o < 64; o <<= 1) { const float t = shup(v, o, lane); if (lane >= o) v = fmaxf(v, t); }
    return v;
}
__device__ __forceinline__ float silu_f(float x) { return x * __builtin_amdgcn_rcpf(1.0f + __expf(-x)); }
__device__ __forceinline__ float sigmoid_f(float x) { return __builtin_amdgcn_rcpf(1.0f + __expf(-x)); }
__device__ __forceinline__ float log1p01(float e) {
    const float s = e / (2.0f + e), s2 = s * s;
    return 2.0f * s * (1.0f + s2 * (0.333333333f + s2 * (0.2f + s2 * (0.142857143f + s2 * (0.111111111f + s2 * 0.0909090909f)))));
}
__device__ __forceinline__ float logsig_f(float x) { return x >= 0.f ? -log1p01(__expf(-x)) : x - log1p01(__expf(x)); }
__device__ __forceinline__ float ret_logg(int h) {
    return h == 0 ? -0.031748698314580301f : (h == 1 ? -0.015748356968139168f : (h == 2 ? -0.0078431774610258787f : -0.0039138993211363287f));
}

__device__ __forceinline__ void phase_init(const Params& p) {
    const int gtid = opq_bid() * NTHR + opq_tid(), gn = opq_gdim() * NTHR;
    float* retc = (float*)(p.ws + OFF_TAB); float* rets = retc + 4096 * 64; float* difc = rets + 4096 * 64; float* difs = difc + 4096 * 16;
    for (int i = gtid; i < 4096 * 64; i += gn) {
        const int pos = i >> 6, j = i & 63; const float inv = powf(10000.0f, -(float)(2 * j) / 128.0f); const float ang = (float)pos * inv;
        retc[i] = cosf(ang); rets[i] = sinf(ang); }
    for (int i = gtid; i < 4096 * 16; i += gn) {
        const int pos = i >> 4, j = i & 15; const float inv = powf(500000.0f, -(float)(2 * j) / 32.0f); const float ang = (float)pos * inv;
        difc[i] = cosf(ang); difs[i] = sinf(ang); }
    const float4* x4 = (const float4*)p.in[0]; uint2* xb = (uint2*)(p.ws + OFF_XB);
    for (int i0 = gtid; i0 < T_ * DM / 4; i0 += 4 * gn) {
        float4 v[4];
#pragma unroll
        for (int e = 0; e < 4; ++e) v[e] = (i0 + e * gn < T_ * DM / 4) ? x4[i0 + e * gn] : make_float4(0.f, 0.f, 0.f, 0.f);
#pragma unroll
        for (int e = 0; e < 4; ++e) if (i0 + e * gn < T_ * DM / 4) { uint2 w; w.x = pk2(v[e].x, v[e].y); w.y = pk2(v[e].z, v[e].w); xb[i0 + e * gn] = w; }
    }
    float* zero = (float*)(p.ws + OFF_CS);
    for (int i = gtid; i < (int)(SZ_CS / 4); i += gn) zero[i] = 0.f;
}

__device__ __forceinline__ int win_row(int n) {
    const int pn = n >> 8, c = n & 255, g = c >> 7, j = c & 127;
    if (pn < 4) return 256 * pn + 128 * (j >> 6) + 64 * g + (j & 63);
    if (pn >= 8 && pn < 16) {
        if (j < 16) return 256 * pn + 16 * g + j;
        if (j < 32) return 256 * pn + 128 + 16 * g + (j - 16);
        if (j < 80) return 256 * pn + 32 + 48 * g + (j - 32);
        return 256 * pn + 128 + 32 + 48 * g + (j - 80);
    }
    return n;
}
template <int MODE>
__device__ __forceinline__ void convert_T(const float* __restrict__ W, int K, int ldn, int ncols, u16* __restrict__ Wt, float* tile) {
    const int tk = K / 64, tn = ncols / 64, nt = tk * tn, t = opq_tid();
    const int per = (nt + opq_gdim() - 1) / opq_gdim(), t0 = opq_bid() * per, t1 = (t0 + per < nt) ? t0 + per : nt;
    if (t0 >= t1) return;
    const int lr = t >> 4, lc = (t & 15) * 4;
    const int nn = t >> 3, k8 = (t & 7) * 8;
    f32x4_t ra[4], rb[4];
#define CT_LOAD(d, tix) do { const int k_ = ((tix) / tn) * 64, n_ = ((tix) % tn) * 64; const float* s_ = W + (size_t)(k_ + lr) * ldn + n_ + lc; ra[d] = *(const f32x4_t*)s_; rb[d] = *(const f32x4_t*)(s_ + (size_t)32 * ldn); } while (0)
    CT_LOAD(0, t0);
    if (t0 + 1 < t1) CT_LOAD(1, t0 + 1);
    if (t0 + 2 < t1) CT_LOAD(2, t0 + 2);
    for (int ti = t0; ti < t1; ++ti) {
        const int k0 = (ti / tn) * 64, n0 = (ti % tn) * 64;
        if (ti + 3 < t1) CT_LOAD(3, ti + 3);
        __syncthreads();
#pragma unroll
        for (int e = 0; e < 4; ++e) { tile[lr * 65 + lc + e] = ra[0][e]; tile[(lr + 32) * 65 + lc + e] = rb[0][e]; }
        __syncthreads();
        float wv[8];
#pragma unroll
        for (int j = 0; j < 8; ++j) wv[j] = tile[(k8 + j) * 65 + nn];
        const int n = n0 + nn;
        const int row = MODE == 0 ? n : (MODE == 1 ? (256 * ((n % DFF) / 128) + 128 * (n / DFF) + (n % 128)) : win_row(n));
        uint4 w; w.x = pk2(wv[0], wv[1]); w.y = pk2(wv[2], wv[3]); w.z = pk2(wv[4], wv[5]); w.w = pk2(wv[6], wv[7]);
        *(uint4*)(Wt + (size_t)row * K + k0 + k8) = w;
#pragma unroll
        for (int d = 0; d < 3; ++d) { ra[d] = ra[d + 1]; rb[d] = rb[d + 1]; }
    }
#undef CT_LOAD
}
__device__ __forceinline__ void phase_weights(const Params& p, int l, unsigned char* lds) {
    float* tile = (float*)lds;
    convert_T<1>(p.in[3] + (size_t)l * DM * NGU, DM, NGU, NGU, (u16*)(p.ws + OFF_WGU1), tile);
    convert_T<0>(p.in[4] + (size_t)l * DFF * DM, DFF, DM, DM, (u16*)(p.ws + OFF_WD1), tile);
    convert_T<2>(p.in[5] + (size_t)l * DM * PW, DM, PW, NPJ, (u16*)(p.ws + OFF_WIN), tile);
    convert_T<0>(p.in[13] + (size_t)l * DM * DM, DM, DM, DM, (u16*)(p.ws + OFF_WOUT), tile);
    convert_T<1>(p.in[14] + (size_t)l * DM * NGU, DM, NGU, NGU, (u16*)(p.ws + OFF_WGU2), tile);
    convert_T<0>(p.in[15] + (size_t)l * DFF * DM, DFF, DM, DM, (u16*)(p.ws + OFF_WD2), tile);
}

__device__ __forceinline__ void row_mr(const float* st, int row, float& mean, float& rstd) { const float2 v = *(const float2*)(st + (size_t)row * 2); mean = v.x; rstd = v.y; }
struct EpiSwiGLU {
    static constexpr bool PERM = true, AFTER_DRAIN = false;
    u16* H;
    __device__ __forceinline__ void operator()(const pg8::f32x4 (&acc)[2][2][4][2], const pg8::Unit& u, int wr, int wc, int fr, int fq) const {
        const int row0 = u.pm * 256 + wr * 64 + fr, col0 = u.pn * 128 + wc * 32 + 8 * fq;
#pragma unroll
        for (int ai = 0; ai < 2; ++ai)
#pragma unroll
            for (int m = 0; m < 4; ++m) {
                u16* rowp = H + (size_t)(row0 + ai * 128 + m * 16) * DFF + col0;
                const pg8::f32x4 g0 = acc[ai][0][m][0], g1 = acc[ai][0][m][1], u0 = acc[ai][1][m][0], u1 = acc[ai][1][m][1];
                float h[8];
#pragma unroll
                for (int j = 0; j < 4; ++j) { h[j] = silu_f(g0[j]) * u0[j]; h[4 + j] = silu_f(g1[j]) * u1[j]; }
                pg8::u32x4 w; w.x = pg8::cvt_pk_bf16(h[0], h[1]); w.y = pg8::cvt_pk_bf16(h[2], h[3]); w.z = pg8::cvt_pk_bf16(h[4], h[5]); w.w = pg8::cvt_pk_bf16(h[6], h[7]);
                *(pg8::u32x4*)rowp = w;
            }
    }
};
struct EpiProjBM {
    static constexpr bool PERM = true, AFTER_DRAIN = false;
    u16* O; const float* tab;
    __device__ __forceinline__ static void st8(u16* p, const pg8::f32x4& a, const pg8::f32x4& b) {
        pg8::u32x4 w; w.x = pg8::cvt_pk_bf16(a[0], a[1]); w.y = pg8::cvt_pk_bf16(a[2], a[3]); w.z = pg8::cvt_pk_bf16(b[0], b[1]); w.w = pg8::cvt_pk_bf16(b[2], b[3]);
        *(pg8::u32x4*)p = w;
    }
    __device__ __forceinline__ void operator()(const pg8::f32x4 (&acc)[2][2][4][2], const pg8::Unit& u, int wr, int wc, int fr, int fq) const {
        const int row0 = u.pm * 256 + wr * 64 + fr, x0 = wc * 32 + 8 * fq;
        const bool ret_u = u.pn < 4, dif_u = u.pn >= 8 && u.pn < 16;
        if (ret_u) {
            const int head = x0 >> 6, jj = x0 & 63; const float sc = u.pn >= 2 ? 0.08838834764831845f : 1.0f;
            u16* blk = O + (size_t)(2 * u.pn + head) * PBLK + jj;
#pragma unroll
            for (int ai = 0; ai < 2; ++ai)
#pragma unroll
                for (int m = 0; m < 4; ++m) {
                    const int row = row0 + ai * 128 + m * 16; const float* ct = tab + (size_t)(row & 4095) * 64 + jj; const float* st = ct + 4096 * 64;
                    const pg8::f32x4 c0 = *(const pg8::f32x4*)ct, c1 = *(const pg8::f32x4*)(ct + 4), s0 = *(const pg8::f32x4*)st, s1 = *(const pg8::f32x4*)(st + 4);
                    const pg8::f32x4 a0 = acc[ai][0][m][0], a1 = acc[ai][0][m][1], b0 = acc[ai][1][m][0], b1 = acc[ai][1][m][1];
                    st8(blk + (size_t)row * 128, (a0 * c0 - b0 * s0) * sc, (a1 * c1 - b1 * s1) * sc);
                    st8(blk + (size_t)row * 128 + 64, (a0 * s0 + b0 * c0) * sc, (a1 * s1 + b1 * c1) * sc);
                }
        } else if (dif_u && wc == 0) {
            const int g = x0 >> 4, jj = x0 & 15;
            u16* blk = O + (size_t)(2 * u.pn + g) * PBLK + jj;
            const float* dtab = tab + 2 * 4096 * 64;
#pragma unroll
            for (int ai = 0; ai < 2; ++ai)
#pragma unroll
                for (int m = 0; m < 4; ++m) {
                    const int row = row0 + ai * 128 + m * 16; const float* ct = dtab + (size_t)(row & 4095) * 16 + jj; const float* st = ct + 4096 * 16;
                    const pg8::f32x4 c0 = *(const pg8::f32x4*)ct, c1 = *(const pg8::f32x4*)(ct + 4), s0 = *(const pg8::f32x4*)st, s1 = *(const pg8::f32x4*)(st + 4);
                    const pg8::f32x4 a0 = acc[ai][0][m][0], a1 = acc[ai][0][m][1], b0 = acc[ai][1][m][0], b1 = acc[ai][1][m][1];
                    st8(blk + (size_t)row * 128, a0 * c0 - b0 * s0, a1 * c1 - b1 * s1);
                    st8(blk + (size_t)row * 128 + 16, a0 * s0 + b0 * c0, a1 * s1 + b1 * c1);
                }
        } else {
#pragma unroll
            for (int bj = 0; bj < 2; ++bj) {
                int blkid = 2 * u.pn + bj, col = x0;
                if (dif_u) { const int g = x0 >= 80; blkid = 2 * u.pn + g; col = (bj == 0) ? (g ? x0 - 48 : x0) : (g ? x0 : x0 + 48); }
                u16* blk = O + (size_t)blkid * PBLK + col;
#pragma unroll
                for (int ai = 0; ai < 2; ++ai)
#pragma unroll
                    for (int m = 0; m < 4; ++m) st8(blk + (size_t)(row0 + ai * 128 + m * 16) * 128, acc[ai][bj][m][0], acc[ai][bj][m][1]);
            }
        }
    }
};
struct EpiResid {
    static constexpr bool PERM = false, AFTER_DRAIN = false;
    const float* Zp; const float* pst; const float* pg; const float* pb; float* Z; float alpha, s;
    __device__ __forceinline__ void operator()(const pg8::f32x4 (&acc)[2][2][4][2], const pg8::Unit& u, int wr, int wc, int fr, int fq) const {
        const int row0 = u.pm * 256 + wr * 64 + fr, col0 = u.pn * 256 + wc * 32 + 4 * fq;
        float mean[2][4], rstd[2][4];
#pragma unroll
        for (int ai = 0; ai < 2; ++ai)
#pragma unroll
            for (int m = 0; m < 4; ++m) { mean[ai][m] = 0.f; rstd[ai][m] = 1.f; if (pst) row_mr(pst, row0 + ai * 128 + m * 16, mean[ai][m], rstd[ai][m]); }
#pragma unroll
        for (int bj = 0; bj < 2; ++bj)
#pragma unroll
            for (int n = 0; n < 2; ++n) {
                const int co = bj * 128 + n * 16;
                pg8::f32x4 gv = {1.f, 1.f, 1.f, 1.f}, bv = {0.f, 0.f, 0.f, 0.f};
                if (pst) { gv = *(const pg8::f32x4*)(pg + col0 + co); bv = *(const pg8::f32x4*)(pb + col0 + co); }
#pragma unroll
                for (int ai = 0; ai < 2; ++ai)
#pragma unroll
                    for (int m = 0; m < 4; ++m) {
                        const size_t off = (size_t)(row0 + ai * 128 + m * 16) * DM + col0 + co;
                        pg8::f32x4 xv = *(const pg8::f32x4*)(Zp + off);
                        if (pst) xv = (xv - mean[ai][m]) * rstd[ai][m] * gv + bv;
                        *(pg8::f32x4*)(Z + off) = xv * alpha + acc[ai][bj][m][n] * s;
                    }
            }
    }
};
template <class Epi>
__device__ __forceinline__ void run_gemm(unsigned char* lds, const u16* A, const u16* Bt, int M, int N, int K, const Epi& E) {
    pg8::Gemm g; g.A = A; g.Bt = Bt; g.M = M; g.N = N; g.K = K;
    pg8::StaticOrder S; S.init(M, N, opq_gdim(), opq_bid());
    pg8::gemm_phase<Epi, pg8::StaticOrder, false>((PG8_LAS unsigned char*)lds, g, S, E, nullptr);
}

template <bool GATES, bool FINAL>
__device__ __forceinline__ void phase_ln(const float* __restrict__ Z, const float* __restrict__ g, const float* __restrict__ b, float* __restrict__ X, u16* __restrict__ xb, float* __restrict__ st,
                         const float* __restrict__ w_in_l, const float* __restrict__ gate_b, float* __restrict__ gates, float* ldsf) {
    const int tid = opq_tid(), wid = tid >> 6, lane = tid & 63;
    if (GATES) {
        __syncthreads();
        float gw[32];
#pragma unroll
        for (int e = 0; e < 32; ++e) { const int i = tid + NTHR * e; gw[e] = w_in_l[(size_t)(i >> 3) * PW + NPJ + (i & 7)]; }
#pragma unroll
        for (int e = 0; e < 32; ++e) { const int i = tid + NTHR * e; ldsf[(i & 7) * 2048 + (i >> 3)] = gw[e]; }
        __syncthreads();
    }
    for (int row0 = (opq_bid() * 8 + wid) * 2; row0 < T_; row0 += opq_gdim() * 16) {
        f32x4_t v[2][8];
#pragma unroll
        for (int rr = 0; rr < 2; ++rr)
#pragma unroll
            for (int i = 0; i < 8; ++i) v[rr][i] = *(const f32x4_t*)(Z + (size_t)(row0 + rr) * DM + 4 * (lane + 64 * i));
#pragma unroll
        for (int rr = 0; rr < 2; ++rr) {
            const int row = row0 + rr;
            float sm = 0.f;
#pragma unroll
            for (int i = 0; i < 8; ++i) sm += (v[rr][i][0] + v[rr][i][1]) + (v[rr][i][2] + v[rr][i][3]);
            const float mean = wave_sum(sm, lane) * (1.0f / 2048.0f);
            float qq = 0.f;
#pragma unroll
            for (int i = 0; i < 8; ++i) { const f32x4_t a = v[rr][i] - mean; qq += (a[0] * a[0] + a[1] * a[1]) + (a[2] * a[2] + a[3] * a[3]); }
            const float rstd = __builtin_amdgcn_rsqf(wave_sum(qq, lane) * (1.0f / 2048.0f) + 1e-5f);
            if (!FINAL && lane == 0) *(float2*)(st + (size_t)row * 2) = make_float2(mean, rstd);
#pragma unroll
            for (int i = 0; i < 8; ++i) {
                const int c4 = lane + 64 * i;
                const f32x4_t gv = *(const f32x4_t*)(g + 4 * c4), bv = *(const f32x4_t*)(b + 4 * c4);
                const f32x4_t y = (v[rr][i] - mean) * rstd * gv + bv;
                if (FINAL) *(f32x4_t*)(X + (size_t)row * DM + 4 * c4) = y;
                else { uint2 w; w.x = pk2(y[0], y[1]); w.y = pk2(y[2], y[3]); *(uint2*)(xb + (size_t)row * DM + 4 * c4) = w; }
                v[rr][i] = y;
            }
        }
        if (GATES) {
#pragma unroll 1
            for (int j = 0; j < 8; ++j) {
                float a0 = 0.f, a1 = 0.f;
#pragma unroll
                for (int i = 0; i < 8; ++i) { const f32x4_t wv = *(const f32x4_t*)(ldsf + j * 2048 + 4 * (lane + 64 * i)); const f32x4_t p0 = v[0][i] * wv, p1 = v[1][i] * wv; a0 += (p0[0] + p0[1]) + (p0[2] + p0[3]); a1 += (p1[0] + p1[1]) + (p1[2] + p1[3]); }
                a0 = wave_sum(a0, lane); a1 = wave_sum(a1, lane);
                if (lane == 0) { gates[(size_t)row0 * 8 + j] = a0 + gate_b[j]; gates[(size_t)(row0 + 1) * 8 + j] = a1 + gate_b[j]; }
            }
        }
    }
}

__device__ __forceinline__ void rot8c(u16* pa, u16* pb, u32x4_t a, u32x4_t b, f32x4_t c0, f32x4_t c1, f32x4_t s0, f32x4_t s1, float sc) {
    u32x4_t oa, ob;
#pragma unroll
    for (int k = 0; k < 4; ++k) {
        const float t1l = bf2f((u16)(a[k] & 0xffff)), t1h = bf2f((u16)(a[k] >> 16)), t2l = bf2f((u16)(b[k] & 0xffff)), t2h = bf2f((u16)(b[k] >> 16));
        const float cl = k < 2 ? c0[2 * k] : c1[2 * k - 4], ch = k < 2 ? c0[2 * k + 1] : c1[2 * k - 3], sl = k < 2 ? s0[2 * k] : s1[2 * k - 4], sh = k < 2 ? s0[2 * k + 1] : s1[2 * k - 3];
        oa[k] = pk2((t1l * cl - t2l * sl) * sc, (t1h * ch - t2h * sh) * sc);
        ob[k] = pk2((t1l * sl + t2l * cl) * sc, (t1h * sh + t2h * ch) * sc);
    }
    *(u32x4_t*)pa = oa; *(u32x4_t*)pb = ob;
}
template <int NI_SHIFT, int DP, int TW>
__device__ __forceinline__ void rot_sweep(u16* proj, const float* ctab, const float* stab, int mode) {
    const int gtid = opq_bid() * NTHR + opq_tid(), gn = opq_gdim() * NTHR;
    const float KS = 0.08838834764831845f;
    for (int i0 = gtid; i0 < (T_ << NI_SHIFT); i0 += 4 * gn) {
        u16* pp[4]; u32x4_t a[4], b[4]; f32x4_t c0[4], c1[4], s0[4], s1[4]; float sc[4]; bool ok[4];
#pragma unroll
        for (int e = 0; e < 4; ++e) {
            const int i = i0 + e * gn; ok[e] = i < (T_ << NI_SHIFT);
            const int t = ok[e] ? i >> NI_SHIFT : 0, r = i & ((1 << NI_SHIFT) - 1), s = t & 4095;
            int blk, j0;
            if (mode == 0) { const int qk = r >> 5, h = (r >> 3) & 3; j0 = (r & 7) * 8; blk = qk * 4 + h; sc[e] = qk ? KS : 1.0f; }
            else { const int grp = r >> 1; j0 = (r & 1) * 8; blk = 16 + grp; sc[e] = 1.0f; }
            pp[e] = proj + (size_t)blk * PBLK + (size_t)t * 128 + j0;
            a[e] = *(const u32x4_t*)pp[e]; b[e] = *(const u32x4_t*)(pp[e] + DP);
            const float* ct = ctab + s * TW + j0; const float* st = stab + s * TW + j0;
            c0[e] = *(const f32x4_t*)ct; c1[e] = *(const f32x4_t*)(ct + 4); s0[e] = *(const f32x4_t*)st; s1[e] = *(const f32x4_t*)(st + 4);
        }
#pragma unroll
        for (int e = 0; e < 4; ++e) if (ok[e]) rot8c(pp[e], pp[e] + DP, a[e], b[e], c0[e], c1[e], s0[e], s1[e], sc[e]);
    }
}
__device__ __forceinline__ void phase_prep(const Params& p, int l) {
    const int gtid = opq_bid() * NTHR + opq_tid(), gn = opq_gdim() * NTHR;
    u16* proj = (u16*)(p.ws + OFF_HP); u16* mqk = (u16*)(p.ws + OFF_MQK);
    const float* retc = (const float*)(p.ws + OFF_TAB); const float* rets = retc + 4096 * 64; const float* difc = rets + 4096 * 64; const float* difs = difc + 4096 * 16;
    const float KS = 0.08838834764831845f;
    const float* cw = p.in[9] + (size_t)l * 4 * 1024; const float* cb = p.in[10] + (size_t)l * 1024;
    const int c0 = (gtid & 127) * 8;
    f32x4_t w[4][2], bb[2];
#pragma unroll
    for (int j = 0; j < 4; ++j) { w[j][0] = *(const f32x4_t*)(cw + j * 1024 + c0); w[j][1] = *(const f32x4_t*)(cw + j * 1024 + c0 + 4); }
    bb[0] = *(const f32x4_t*)(cb + c0); bb[1] = *(const f32x4_t*)(cb + c0 + 4);
    const u16* src = proj + (size_t)(40 + (c0 >> 7)) * PBLK + (c0 & 127);
    u16* dst = mqk + (size_t)(c0 >> 7) * PBLK + (c0 & 127);
    const float sck = c0 >= 512 ? KS : 1.0f;
    for (int i0 = gtid; i0 < T_ * 128; i0 += 4 * gn) {
        u32x4_t x[4][4];
#pragma unroll
        for (int e = 0; e < 4; ++e) {
            const int i = i0 + e * gn, t = i < T_ * 128 ? i >> 7 : 0, s = t & 4095;
#pragma unroll
            for (int j = 0; j < 4; ++j) x[e][j] = (s - 3 + j >= 0) ? *(const u32x4_t*)(src + (size_t)(t - 3 + j) * 128) : (u32x4_t){0u, 0u, 0u, 0u};
        }
#pragma unroll
        for (int e = 0; e < 4; ++e) {
            const int i = i0 + e * gn;
            if (i < T_ * 128) {
                const int t = i >> 7;
                f32x4_t y0 = bb[0], y1 = bb[1];
#pragma unroll
                for (int j = 0; j < 4; ++j) {
                    const u32x4_t xv = x[e][j];
                    const f32x4_t lo = {bf2f((u16)(xv[0] & 0xffff)), bf2f((u16)(xv[0] >> 16)), bf2f((u16)(xv[1] & 0xffff)), bf2f((u16)(xv[1] >> 16))};
                    const f32x4_t hi = {bf2f((u16)(xv[2] & 0xffff)), bf2f((u16)(xv[2] >> 16)), bf2f((u16)(xv[3] & 0xffff)), bf2f((u16)(xv[3] >> 16))};
                    y0 += w[j][0] * lo; y1 += w[j][1] * hi;
                }
                u32x4_t o;
                o[0] = pk2(silu_f(y0[0]) * sck, silu_f(y0[1]) * sck); o[1] = pk2(silu_f(y0[2]) * sck, silu_f(y0[3]) * sck);
                o[2] = pk2(silu_f(y1[0]) * sck, silu_f(y1[1]) * sck); o[3] = pk2(silu_f(y1[2]) * sck, silu_f(y1[3]) * sck);
                *(u32x4_t*)(dst + (size_t)t * 128) = o;
            }
        }
    }
}

__device__ __forceinline__ da::BlockRef<__hip_bfloat16, float> diff_ref(int inst, int qb, const __hip_bfloat16* proj, float* Od) {
    const int b = inst >> 4, h = (inst >> 2) & 3, m = (inst >> 1) & 1, e = inst & 1;
    da::BlockRef<__hip_bfloat16, float> r;
    r.Q = proj + (size_t)(16 + 2 * h + m) * PBLK + (size_t)(b * 4096 + qb * 256) * 128;
    r.K = proj + (size_t)(24 + 2 * h + m) * PBLK + (size_t)(b * 4096) * 128;
    r.V = proj + (size_t)(32 + 2 * h + e) * PBLK + (size_t)(b * 4096) * 128;
    r.O = Od + (size_t)(b * 4096 + qb * 256) * DM + h * 512 + m * 256 + e * 128;
    r.P0 = qb * 256;
    return r;
}
__device__ __forceinline__ void phase_diffattn(const Params& p, unsigned char* lds) {
    typedef __hip_bfloat16 TI;
    const TI* proj = (const TI*)(p.ws + OFF_HP); float* Od = p.out;
    const int total = 512, stride = opq_gdim();
    const int Wrt = 4096 + (p.ws == nullptr ? 64 : 0), SKVrt = 4096 + (p.out == nullptr ? 64 : 0);
#define IT_INST(L_) ((((L_) & 7) << 3) + ((L_) >> 6))
#define IT_X(L_) (((L_) >> 3) & 7)
    int L = opq_bid(); if (L >= total) return;
    int pass = 0;
    da::BlockRef<TI, float> cur = diff_ref(IT_INST(L), IT_X(L), proj, Od);
    da::Seam<TI> S;
    da::causal_swa_prime<TI, float>(cur, Wrt, (char*)lds, S);
    for (;;) {
        const bool more_pass = pass == 0, more_item = L + stride < total, last = !more_pass && !more_item;
        int passn = pass + 1, Ln = L;
        if (!more_pass) { passn = 0; Ln = more_item ? L + stride : L; }
        const int qbn = passn ? 15 - IT_X(Ln) : IT_X(Ln);
        const da::BlockRef<TI, float> nxt = last ? cur : diff_ref(IT_INST(Ln), qbn, proj, Od);
        da::causal_swa_block<TI, float>(cur, nxt, SKVrt, Wrt, (char*)lds, S);
        if (last) break;
        cur = nxt; pass = passn; L = Ln;
    }
}
__device__ __forceinline__ void phase_diffcomb(const Params& p, int l) {
    const int tid = opq_tid(), wid = tid >> 6, lane = tid & 63;
    const float* Od = p.out; u16* mixed = (u16*)(p.ws + OFF_MIX);
    const float* dl = p.in[7] + (size_t)l * 512; const float* g = p.in[8] + (size_t)l * 256;
    const float lam_init = 0.8f - 0.6f * __expf(-0.3f * (float)l);
    const float s1 = wave_sum(dl[lane] * dl[128 + lane] + dl[64 + lane] * dl[192 + lane], lane);
    const float s2 = wave_sum(dl[256 + lane] * dl[384 + lane] + dl[320 + lane] * dl[448 + lane], lane);
    const float lam = __expf(s1) - __expf(s2) + lam_init;
    const float4 gv = ((const float4*)g)[lane];
    const float post = 1.0f - lam_init;
    for (int u0 = (opq_bid() * 8 + wid) * 4; u0 < T_ * 4; u0 += opq_gdim() * 32) {
        float4 a0[4], a1[4];
#pragma unroll
        for (int k = 0; k < 4; ++k) { const float4* o0 = (const float4*)(Od + (size_t)(u0 >> 2) * DM + k * 512); a0[k] = o0[lane]; a1[k] = o0[64 + lane]; }
#pragma unroll
        for (int k = 0; k < 4; ++k) {
            float4 v; v.x = a0[k].x - lam * a1[k].x; v.y = a0[k].y - lam * a1[k].y; v.z = a0[k].z - lam * a1[k].z; v.w = a0[k].w - lam * a1[k].w;
            const float ss = wave_sum((v.x * v.x + v.y * v.y) + (v.z * v.z + v.w * v.w), lane);
            const float rms = __builtin_amdgcn_rsqf(ss * (1.0f / 256.0f) + 1e-6f) * post;
            uint2 w; w.x = pk2(v.x * rms * gv.x, v.y * rms * gv.y); w.y = pk2(v.z * rms * gv.z, v.w * rms * gv.w);
            *(uint2*)(mixed + (size_t)(u0 >> 2) * DM + 512 + k * 256 + 4 * lane) = w;
        }
    }
}

__device__ __forceinline__ bf16x8_t frag(const u16* tile, int row0, int k0, int lane) {
    return *(const bf16x8_t*)(tile + (row0 + (lane & 15)) * LDT + k0 + 8 * (lane >> 4));
}
#define TILE_LOAD(rg, TR, src, ld) do { _Pragma("unroll") for (int k_ = 0; k_ < L / 32; ++k_) { const int i_ = tid + NTHR * k_; \
        const int r_ = (TR) ? (((i_ % L) + rot) & (L - 1)) : (((i_ >> 4) + rot) & (L - 1)), c_ = (TR) ? (i_ / L) * 8 : (i_ & 15) * 8; \
        rg[k_] = *(const u32x4_t*)((src) + (size_t)r_ * (ld) + c_); } } while (0)
#define TILE_STORE_ROWS(dst, rg) do { _Pragma("unroll") for (int k_ = 0; k_ < L / 32; ++k_) { const int i_ = tid + NTHR * k_, r_ = ((i_ >> 4) + rot) & (L - 1), c_ = (i_ & 15) * 8; \
        *(u32x4_t*)((dst) + r_ * LDT + c_) = rg[k_]; } } while (0)
__device__ __forceinline__ void store_T8(u16* dst, int c8, int r, u32x4_t v, const float* rowscale) {
    const float sc = rowscale ? rowscale[r] : 1.0f;
#pragma unroll
    for (int q = 0; q < 4; ++q) {
        u16 lo = (u16)(v[q] & 0xffff), hi = (u16)(v[q] >> 16);
        if (rowscale) { lo = f2bf(bf2f(lo) * sc); hi = f2bf(bf2f(hi) * sc); }
        dst[(c8 + 2 * q) * LDT + r] = lo; dst[(c8 + 2 * q + 1) * LDT + r] = hi;
    }
}
#define TILE_STORE_T(dst, rg, rowscale) do { _Pragma("unroll") for (int k_ = 0; k_ < L / 32; ++k_) { const int i_ = tid + NTHR * k_, r_ = ((i_ % L) + rot) & (L - 1), c_ = (i_ / L) * 8; \
        store_T8((dst), c_, r_, rg[k_], (rowscale)); } } while (0)
template <int TYPE>
__device__ __forceinline__ void chunk_l1(const Params& p, unsigned char* lds) {
    constexpr int L = TYPE ? 64 : 128, NC = 4096 / L, NIT = 16 * NC;
    const int tid = opq_tid(), wid = tid >> 6, lane = tid & 63;
    u16* sK = (u16*)lds; u16* sV = sK + 128 * LDT; float* sW = (float*)(lds + 2 * 128 * LDT * 2);
    const u16* proj = (const u16*)(p.ws + OFF_HP); const u16* mqk = (const u16*)(p.ws + OFF_MQK); const float* gates = (const float*)(p.ws + OFF_GATE);
    float* ST = (float*)(p.ws + (TYPE ? OFF_STM : OFF_STR)); float* nm = (float*)(p.ws + OFF_NM); float* scb = (float*)(p.ws + OFF_SC);
    for (int it = opq_bid(); it < NIT; it += opq_gdim()) {
        const int bh = it / NC, c = it % NC, b = bh >> 2, h = bh & 3; const size_t t0 = (size_t)b * 4096 + (size_t)c * L;
        const int rot = (opq_bid() * 29) & (L - 1);
        u32x4_t rk[L / 32], rv[L / 32];
        if (TYPE == 0) { TILE_LOAD(rk, true, proj + (size_t)(4 + h) * PBLK + t0 * 128, 128); TILE_LOAD(rv, true, proj + (size_t)(8 + h) * PBLK + t0 * 128, 128); }
        else           { TILE_LOAD(rk, true, mqk + (size_t)(4 + h) * PBLK + t0 * 128, 128); TILE_LOAD(rv, true, proj + (size_t)(48 + h) * PBLK + t0 * 128, 128); }
        float fp = 0.f, ip = 0.f;
        if (TYPE == 1 && wid == 0) { fp = gates[(t0 + lane) * 8 + 4 + h]; ip = gates[(t0 + lane) * 8 + h]; }
        __syncthreads();
        if (TYPE == 0) { if (tid < 128) { const float lg = ret_logg(h); sW[tid] = __expf((float)(127 - tid) * lg); } }
        else if (wid == 0) {
            const float bb = scan_sum(logsig_f(fp), lane), bL = __int_as_float(__builtin_amdgcn_readlane(__float_as_int(bb), 63)), wl = bL - bb + ip, wmax = wave_max(wl, lane);
            sW[lane] = __expf(wl - wmax);
            if (lane == 0) { scb[(bh * 64 + c) * 4 + 0] = bL; scb[(bh * 64 + c) * 4 + 1] = wmax; }
        }
        __syncthreads();
        TILE_STORE_T(sK, rk, sW); TILE_STORE_T(sV, rv, (const float*)nullptr);
        __syncthreads();
        f32x4_t acc[8];
#pragma unroll
        for (int ct = 0; ct < 8; ++ct) acc[ct] = (f32x4_t){0.f, 0.f, 0.f, 0.f};
        for (int j0 = 0; j0 < L; j0 += 32) {
            const bf16x8_t a = frag(sK, 16 * wid, j0, lane);
#pragma unroll
            for (int ct = 0; ct < 8; ++ct) { const bf16x8_t bb = frag(sV, 16 * ct, j0, lane); acc[ct] = __builtin_amdgcn_mfma_f32_16x16x32_bf16(a, bb, acc[ct], 0, 0, 0); }
        }
        float* dst = ST + (size_t)(bh * NC + c) * 16384;
#pragma unroll
        for (int ct = 0; ct < 8; ++ct)
#pragma unroll
            for (int r = 0; r < 4; ++r) dst[(16 * wid + 4 * (lane >> 4) + r) * 128 + 16 * ct + (lane & 15)] = acc[ct][r];
        if (TYPE == 1 && tid < 128) { float s = 0.f; for (int j = 0; j < L; ++j) s += bf2f(sK[tid * LDT + j]); nm[(size_t)(bh * 64 + c) * 128 + tid] = s; }
    }
}
__device__ __forceinline__ void chunk_scan(const Params& p) {
    const int gtid = opq_bid() * NTHR + opq_tid(), gn = opq_gdim() * NTHR;
    float* str = (float*)(p.ws + OFF_STR); float* stm = (float*)(p.ws + OFF_STM); float* nm = (float*)(p.ws + OFF_NM); float* scb = (float*)(p.ws + OFF_SC);
    for (int u = gtid; u < 2 * 65536 + 2048; u += gn) {
        if (u < 65536) {
            const int bh = u >> 12, e4 = u & 4095, h = bh & 3;
            const float lg = ret_logg(h), dec = __expf(128.0f * lg);
            float4* ptr = (float4*)(str + (size_t)bh * 32 * 16384) + e4; float4 C = make_float4(0.f, 0.f, 0.f, 0.f);
#pragma unroll 16
            for (int c = 0; c < 32; ++c) { const float4 kv = ptr[(size_t)c * 4096]; ptr[(size_t)c * 4096] = C; C.x = dec * C.x + kv.x; C.y = dec * C.y + kv.y; C.z = dec * C.z + kv.z; C.w = dec * C.w + kv.w; }
        } else if (u < 2 * 65536) {
            const int v = u - 65536, bh = v >> 12, e4 = v & 4095;
            float4* ptr = (float4*)(stm + (size_t)bh * 64 * 16384) + e4; const float* sp = scb + bh * 64 * 4; float4 C = make_float4(0.f, 0.f, 0.f, 0.f); float m = 0.f;
#pragma unroll 16
            for (int c = 0; c < 64; ++c) {
                const float bL = sp[c * 4], wmax = sp[c * 4 + 1], mn = fmaxf(bL + m, wmax), dec = __expf(bL + m - mn), sc = __expf(wmax - mn);
                const float4 kv = ptr[(size_t)c * 4096]; ptr[(size_t)c * 4096] = C;
                C.x = dec * C.x + sc * kv.x; C.y = dec * C.y + sc * kv.y; C.z = dec * C.z + sc * kv.z; C.w = dec * C.w + sc * kv.w; m = mn; }
        } else {
            const int v = u - 2 * 65536, bh = v >> 7, e = v & 127;
            float* ptr = nm + (size_t)bh * 64 * 128 + e; float* sp = scb + bh * 64 * 4; float C = 0.f, m = 0.f;
#pragma unroll 8
            for (int c = 0; c < 64; ++c) {
                const float bL = sp[c * 4], wmax = sp[c * 4 + 1], mn = fmaxf(bL + m, wmax), dec = __expf(bL + m - mn), sc = __expf(wmax - mn);
                const float kv = ptr[c * 128]; ptr[c * 128] = C; if (e == 0) sp[c * 4 + 2] = m; C = dec * C + sc * kv; m = mn; }
        }
    }
}
template <int TYPE>
__device__ __forceinline__ void chunk_l3(const Params& p, int l, unsigned char* lds) {
    constexpr int L = TYPE ? 64 : 128, NC = 4096 / L, NIT = 16 * NC, NRT = L / 16, WPR = 8 / NRT, NCT = 8 / WPR;
    const int tid = opq_tid(), wid = tid >> 6, lane = tid & 63;
    u16* sQ = (u16*)lds; u16* sK = sQ + 128 * LDT; u16* sV = sK + 128 * LDT; u16* sC = sV + 128 * LDT;
    float* sF = (float*)(lds + 4 * 128 * LDT * 2);
    float* rowoff = sF, * uvec = sF + 128, * inter = sF + 256, * emt = sF + 384, * den = sF + 512, * qn = sF + 640, * nst = sF + 768;
    float* sH = (float*)lds;
    const u16* proj = (const u16*)(p.ws + OFF_HP); const u16* mqk = (const u16*)(p.ws + OFF_MQK); const float* gates = (const float*)(p.ws + OFF_GATE);
    const float* ST = (const float*)(p.ws + (TYPE ? OFF_STM : OFF_STR)); const float* nm = (const float*)(p.ws + OFF_NM); const float* scb = (const float*)(p.ws + OFF_SC);
    u16* mixed = (u16*)(p.ws + OFF_MIX);
    const float* ng = TYPE ? (p.in[12] + (size_t)l * 512) : (p.in[6] + (size_t)l * 512);
    for (int it = opq_bid(); it < NIT; it += opq_gdim()) {
        const int bh = it / NC, c = it % NC, b = bh >> 2, h = bh & 3; const size_t t0 = (size_t)b * 4096 + (size_t)c * L;
        const int rot = (opq_bid() * 29) & (L - 1);
        u32x4_t rq[L / 32], rk[L / 32], rv[L / 32]; f32x4_t rc[8];
        if (TYPE == 0) { TILE_LOAD(rq, false, proj + (size_t)h * PBLK + t0 * 128, 128); TILE_LOAD(rk, false, proj + (size_t)(4 + h) * PBLK + t0 * 128, 128); TILE_LOAD(rv, true, proj + (size_t)(8 + h) * PBLK + t0 * 128, 128); }
        else           { TILE_LOAD(rq, false, mqk + (size_t)h * PBLK + t0 * 128, 128); TILE_LOAD(rk, false, mqk + (size_t)(4 + h) * PBLK + t0 * 128, 128); TILE_LOAD(rv, true, proj + (size_t)(48 + h) * PBLK + t0 * 128, 128); }
        {
            const float4* Cg = (const float4*)(ST + (size_t)(bh * NC + c) * 16384);
#pragma unroll
            for (int k = 0; k < 8; ++k) { const int i = tid + NTHR * k, d = ((i & 127) + 3 * rot) & 127, v0 = (((i >> 7) + rot) & 31) * 4; rc[k] = *(const f32x4_t*)(Cg + d * 32 + (v0 >> 2)); }
        }
        float fp = 0.f, ip = 0.f, m_in = 0.f, nld = 0.f;
        if (TYPE == 1) {
            if (wid == 0) { fp = gates[(t0 + lane) * 8 + 4 + h]; ip = gates[(t0 + lane) * 8 + h]; m_in = scb[(bh * 64 + c) * 4 + 2]; }
            if (tid >= 128 && tid < 256) nld = nm[(size_t)(bh * 64 + c) * 128 + tid - 128];
        }
        __syncthreads();
        TILE_STORE_ROWS(sQ, rq); TILE_STORE_ROWS(sK, rk); TILE_STORE_T(sV, rv, (const float*)nullptr);
#pragma unroll
        for (int k = 0; k < 8; ++k) { const int i = tid + NTHR * k, d = ((i & 127) + 3 * rot) & 127, v0 = (((i >> 7) + rot) & 31) * 4;
            sC[(v0 + 0) * LDT + d] = f2bf(rc[k][0]); sC[(v0 + 1) * LDT + d] = f2bf(rc[k][1]); sC[(v0 + 2) * LDT + d] = f2bf(rc[k][2]); sC[(v0 + 3) * LDT + d] = f2bf(rc[k][3]); }
        if (TYPE == 0) {
            if (tid < 128) { const float lg = ret_logg(h), bi = (float)(tid + 1) * lg; rowoff[tid] = bi; uvec[tid] = -bi; inter[tid] = __expf(bi); emt[tid] = 1.0f; }
        } else {
            if (wid == 0) {
                const float bb = scan_sum(logsig_f(fp), lane), uu = ip - bb, pm = scan_max(uu, lane);
                const float mt = bb + fmaxf(m_in, pm);
                rowoff[lane] = bb - mt; uvec[lane] = uu; inter[lane] = __expf(bb + m_in - mt); emt[lane] = __expf(-mt);
            }
            if (tid >= 128 && tid < 256) nst[tid - 128] = nld;
        }
        __syncthreads();
        unsigned gpre[L / 8];
#pragma unroll
        for (int k = 0; k < L / 8; ++k) gpre[k] = *(const unsigned*)(proj + (size_t)((TYPE ? 52 : 12) + h) * PBLK + (t0 + wid + 8 * k) * 128 + 2 * lane);
        f32x4_t sacc[NRT];
        if (wid < NRT) {
#pragma unroll
            for (int ct = 0; ct < NRT; ++ct) sacc[ct] = (f32x4_t){0.f, 0.f, 0.f, 0.f};
            for (int d0 = 0; d0 < 128; d0 += 32) {
                const bf16x8_t a = frag(sQ, 16 * wid, d0, lane);
#pragma unroll
                for (int ct = 0; ct < NRT; ++ct) { const bf16x8_t bb = frag(sK, 16 * ct, d0, lane); sacc[ct] = __builtin_amdgcn_mfma_f32_16x16x32_bf16(a, bb, sacc[ct], 0, 0, 0); }
            }
        }
        if (TYPE == 1) {
            for (int i = wid; i < L; i += 8) { float s = bf2f(sQ[i * LDT + lane]) * nst[lane] + bf2f(sQ[i * LDT + 64 + lane]) * nst[64 + lane]; s = wave_sum(s, lane); if (lane == 0) qn[i] = s; }
        }
        __syncthreads();
        u16* sP = sK;
        if (wid < NRT) {
#pragma unroll
            for (int r = 0; r < 4; ++r) {
                const int i = 16 * wid + 4 * (lane >> 4) + r; const float ro = rowoff[i]; float rs = 0.f;
#pragma unroll
                for (int ct = 0; ct < NRT; ++ct) { const int j = 16 * ct + (lane & 15); const float pv = (j <= i) ? sacc[ct][r] * __expf(ro + uvec[j]) : 0.f; rs += pv; sP[i * LDT + j] = f2bf(pv); }
                rs += shx(rs, 1, lane); rs += shx(rs, 2, lane); rs += shx(rs, 4, lane); rs += shx(rs, 8, lane);
                if ((lane & 15) == 0) den[i] = rs;
            }
        }
        __syncthreads();
        const int rt = wid % NRT, ctb = (wid / NRT) * NCT;
        f32x4_t acc[NCT];
#pragma unroll
        for (int ct = 0; ct < NCT; ++ct) acc[ct] = (f32x4_t){0.f, 0.f, 0.f, 0.f};
        for (int d0 = 0; d0 < 128; d0 += 32) {
            const bf16x8_t a = frag(sQ, 16 * rt, d0, lane);
#pragma unroll
            for (int ct = 0; ct < NCT; ++ct) { const bf16x8_t bb = frag(sC, 16 * (ctb + ct), d0, lane); acc[ct] = __builtin_amdgcn_mfma_f32_16x16x32_bf16(a, bb, acc[ct], 0, 0, 0); }
        }
#pragma unroll
        for (int r = 0; r < 4; ++r) { const float sc = inter[16 * rt + 4 * (lane >> 4) + r];
#pragma unroll
            for (int ct = 0; ct < NCT; ++ct) acc[ct][r] *= sc; }
        for (int j0 = 0; j0 < L; j0 += 32) {
            const bf16x8_t a = frag(sP, 16 * rt, j0, lane);
#pragma unroll
            for (int ct = 0; ct < NCT; ++ct) { const bf16x8_t bb = frag(sV, 16 * (ctb + ct), j0, lane); acc[ct] = __builtin_amdgcn_mfma_f32_16x16x32_bf16(a, bb, acc[ct], 0, 0, 0); }
        }
        __syncthreads();
#pragma unroll
        for (int ct = 0; ct < NCT; ++ct)
#pragma unroll
            for (int r = 0; r < 4; ++r) sH[(16 * rt + 4 * (lane >> 4) + r) * 129 + 16 * (ctb + ct) + (lane & 15)] = acc[ct][r];
        __syncthreads();
        const float g0 = ng[h * 128 + 2 * lane], g1 = ng[h * 128 + 2 * lane + 1];
#pragma unroll
        for (int k = 0; k < L / 8; ++k) {
            const int i = wid + 8 * k; const size_t t = t0 + i;
            float h0 = sH[i * 129 + 2 * lane], h1 = sH[i * 129 + 2 * lane + 1];
            const float ga = bf2f((u16)(gpre[k] & 0xffff)), gb = bf2f((u16)(gpre[k] >> 16));
            if (TYPE == 1) {
                const float dn = den[i] + inter[i] * qn[i], dd = fmaxf(fabsf(dn), emt[i]);
                const float rdd = __builtin_amdgcn_rcpf(dd); h0 = h0 * rdd * sigmoid_f(ga); h1 = h1 * rdd * sigmoid_f(gb);
            }
            const float mean = wave_sum(h0 + h1, lane) * (1.0f / 128.0f), d0 = h0 - mean, d1 = h1 - mean;
            const float var = wave_sum(d0 * d0 + d1 * d1, lane) * (1.0f / 128.0f), rstd = __builtin_amdgcn_rsqf(var + 1e-6f);
            float y0 = d0 * rstd * g0, y1 = d1 * rstd * g1;
            int col;
            if (TYPE == 0) { y0 *= silu_f(ga); y1 *= silu_f(gb); col = h * 128 + 2 * lane; } else col = 1536 + h * 128 + 2 * lane;
            *(unsigned*)(mixed + t * DM + col) = pk2(y0, y1);
        }
    }
}

__device__ __forceinline__ Params load_params() {
    Params r{};
#if defined(__HIP_DEVICE_COMPILE__)
    const __attribute__((address_space(4))) Params* k = (const __attribute__((address_space(4))) Params*)__builtin_amdgcn_kernarg_segment_ptr();
    asm volatile("" : "+s"(k));
#pragma unroll
    for (int i = 0; i < 16; ++i) r.in[i] = k->in[i];
    r.out = k->out; r.ws = k->ws;
#endif
    return r;
}
#define PWS(off) (q.ws + (off))
#define GSYNC() do { const Params q_ = load_params(); XcdBarrier b_; b_.bar = (unsigned*)(q_.ws + OFF_BAR); b_.x = xb_xcc_id(); b_.st = (volatile LAS unsigned*)((LAS unsigned char*)lds + LDS_PHASE); xcd_barrier(b_); } while (0)
#ifndef PHMASK
#define PHMASK 0xFFFF
#endif
__global__ void __launch_bounds__(NTHR, 2) fwd_megakernel(Params p_unused) {
    extern __shared__ __attribute__((aligned(16))) unsigned char lds[];
    cg::grid_group grid = cg::this_grid();
    volatile LAS unsigned* xst = (volatile LAS unsigned*)((LAS unsigned char*)lds + LDS_PHASE);
    if (opq_tid() == 0) { xst[0] = 0u; xst[1] = 0u; }
    __syncthreads();
    { const Params q = load_params(); (void)xcd_barrier_post((unsigned*)PWS(OFF_BAR), xst); }
    const float ALPHA = 1.41421356237309515f;
    { const Params q = load_params(); phase_init(q); }
    grid.sync();
#define STAT(i) ((float*)PWS(OFF_STAT) + (size_t)(i) * T_ * 2)
#define LNG(i) (q.in[1] + (size_t)(i) * DM)
#define LNB(i) (q.in[2] + (size_t)(i) * DM)
#define CSL(off) ((const float*)PWS(OFF_CS) + (size_t)l * CS_LAYER + (off))
#pragma unroll 1
    for (int l = 0; l < 2; ++l) {
        { const Params q = load_params(); phase_weights(q, l, lds); }
        GSYNC();
        { const Params q = load_params(); EpiSwiGLU e; e.H = (u16*)PWS(OFF_HP); run_gemm(lds, (const u16*)PWS(OFF_XB), (const u16*)PWS(OFF_WGU1), T_, NGU, DM, e); }
        GSYNC();
        { const Params q = load_params(); EpiResid e; e.Zp = l ? (const float*)PWS(OFF_Z) : q.in[0]; e.pst = l ? STAT(2) : nullptr; e.pg = LNG(2); e.pb = LNB(2);
          e.Z = (float*)PWS(OFF_Z); e.alpha = opq_f(ALPHA); e.s = opq_f(0.5f); run_gemm(lds, (const u16*)PWS(OFF_HP), (const u16*)PWS(OFF_WD1), T_, DM, DFF, e); }
        GSYNC();
        { const Params q = load_params(); phase_ln<true, false>((const float*)PWS(OFF_Z), LNG(l * 3 + 0), LNB(l * 3 + 0), nullptr, (u16*)PWS(OFF_XB), STAT(l * 3 + 0), q.in[5] + (size_t)l * DM * PW, q.in[11] + (size_t)l * 8, (float*)PWS(OFF_GATE), (float*)lds); }
        GSYNC();
        { const Params q = load_params(); EpiProjBM e; e.O = (u16*)PWS(OFF_HP); e.tab = (const float*)PWS(OFF_TAB); run_gemm(lds, (const u16*)PWS(OFF_XB), (const u16*)PWS(OFF_WIN), T_, NPJ, DM, e); }
        GSYNC();
        { const Params q = load_params(); phase_prep(q, l); }
        GSYNC();
        { const Params q = load_params(); phase_diffattn(q, lds); }
        { const Params q = load_params(); chunk_l1<0>(q, lds); }
        { const Params q = load_params(); chunk_l1<1>(q, lds); }
        GSYNC();
        { const Params q = load_params(); chunk_scan(q); }
        GSYNC();
        { const Params q = load_params(); chunk_l3<0>(q, l, lds); }
        { const Params q = load_params(); chunk_l3<1>(q, l, lds); }
        { const Params q = load_params(); phase_diffcomb(q, l); }
        GSYNC();
        { const Params q = load_params(); EpiResid e; e.Zp = (const float*)PWS(OFF_Z); e.pst = STAT(l * 3 + 0); e.pg = LNG(l * 3 + 0); e.pb = LNB(l * 3 + 0);
          e.Z = (float*)PWS(OFF_Z); e.alpha = opq_f(ALPHA); e.s = opq_f(1.0f); run_gemm(lds, (const u16*)PWS(OFF_MIX), (const u16*)PWS(OFF_WOUT), T_, DM, DM, e); }
        GSYNC();
        { const Params q = load_params(); phase_ln<false, false>((const float*)PWS(OFF_Z), LNG(l * 3 + 1), LNB(l * 3 + 1), nullptr, (u16*)PWS(OFF_XB), STAT(l * 3 + 1), nullptr, nullptr, nullptr, (float*)lds); }
        GSYNC();
        { const Params q = load_params(); EpiSwiGLU e; e.H = (u16*)PWS(OFF_HP); run_gemm(lds, (const u16*)PWS(OFF_XB), (const u16*)PWS(OFF_WGU2), T_, NGU, DM, e); }
        GSYNC();
        { const Params q = load_params(); EpiResid e; e.Zp = (const float*)PWS(OFF_Z); e.pst = STAT(l * 3 + 1); e.pg = LNG(l * 3 + 1); e.pb = LNB(l * 3 + 1);
          e.Z = (float*)PWS(OFF_Z); e.alpha = opq_f(ALPHA); e.s = opq_f(0.5f); run_gemm(lds, (const u16*)PWS(OFF_HP), (const u16*)PWS(OFF_WD2), T_, DM, DFF, e); }
        GSYNC();
        if (l == 0) { const Params q = load_params(); phase_ln<false, false>((const float*)PWS(OFF_Z), LNG(2), LNB(2), nullptr, (u16*)PWS(OFF_XB), STAT(2), nullptr, nullptr, nullptr, (float*)lds); }
        else        { const Params q = load_params(); phase_ln<false, true>((const float*)PWS(OFF_Z), LNG(5), LNB(5), q.out, nullptr, nullptr, nullptr, nullptr, nullptr, (float*)lds); }
        if (l == 0) GSYNC();
    }
}

extern "C" void kernel_launch(void* const* d_in, const int* in_sizes, int n_in, void* d_out, int out_size, void* d_ws, size_t ws_size, hipStream_t stream) {
    static int grid_blocks = 0;
    if (grid_blocks == 0) {
        if (n_in != 16 || out_size != T_ * DM || ws_size < WS_END) { fprintf(stderr, "kernel_launch: unexpected shapes (n_in %d out %d ws %zu need %zu)\n", n_in, out_size, ws_size, (size_t)WS_END); grid_blocks = -1; return; }
        int dev = 0, cus = 0, per_cu = 0;
        (void)hipGetDevice(&dev);
        (void)hipDeviceGetAttribute(&cus, hipDeviceAttributeMultiprocessorCount, dev);
        if (hipFuncSetAttribute((const void*)fwd_megakernel, hipFuncAttributeMaxDynamicSharedMemorySize, LDS_TOTAL) != hipSuccess) fprintf(stderr, "kernel_launch: hipFuncSetAttribute failed\n");
        if (hipOccupancyMaxActiveBlocksPerMultiprocessor(&per_cu, (const void*)fwd_megakernel, NTHR, LDS_TOTAL) != hipSuccess || per_cu < 1) { fprintf(stderr, "kernel_launch: occupancy query gave %d\n", per_cu); per_cu = 1; }
        (void)hipGetLastError();
        if (cus <= 0) cus = 256;
        grid_blocks = cus * per_cu;
    }
    if (grid_blocks < 0) return;
    if (hipMemsetAsync((unsigned char*)d_ws + OFF_BAR, 0, SZ_BAR, stream) != hipSuccess) { fprintf(stderr, "kernel_launch: memset of the barrier words failed\n"); return; }
    Params p{};
    for (int i = 0; i < 16; ++i) p.in[i] = (const float*)d_in[i];
    p.out = (float*)d_out; p.ws = (unsigned char*)d_ws;
    void* args[] = {&p};
    hipError_t e = hipLaunchCooperativeKernel((const void*)fwd_megakernel, dim3(grid_blocks), dim3(NTHR), args, LDS_TOTAL, stream);
    if (e != hipSuccess) fprintf(stderr, "kernel_launch: cooperative launch failed: %s (grid %d)\n", hipGetErrorString(e), grid_blocks);
}
```
